# Optimizing an MI355X kernel written in HIP

```python
import jax
import jax.numpy as jnp
from jax import lax
import numpy as np

D_MODEL = 1024
BATCH = 4
SEQ = 4096
DEPTH = 1

GRID_W = 64
CTX_LEN = 256
HEAD_DIM = 64
ATTN_WIDTH = D_MODEL // 2
N_Q_HEADS = ATTN_WIDTH // HEAD_DIM
N_KV_HEADS = N_Q_HEADS // 4
Q_PER_KV = N_Q_HEADS // N_KV_HEADS
KV_WIDTH = N_KV_HEADS * HEAD_DIM
WINDOW = 128
BLOCK = 128
ROPE_BASE = 10000.0
RWKV_WIDTH = D_MODEL // 2
RWKV_HEAD_DIM = 64
RWKV_HEADS = RWKV_WIDTH // RWKV_HEAD_DIM
DECAY_LORA = 32
ICLR_LORA = 32
GATE_LORA = 96
RWKV_IN_WIDTH = 3 * RWKV_WIDTH + DECAY_LORA + ICLR_LORA + GATE_LORA
SHORT_CONV = 3
N_BRANCHES = 2
IN_WIDTH = ATTN_WIDTH + 2 * KV_WIDTH + RWKV_IN_WIDTH + N_BRANCHES * D_MODEL
D_FF = 4 * D_MODEL
N_MOD = 6
NORM_EPS = 1e-6
LNX_EPS = 1e-5 * RWKV_HEAD_DIM
IN_SPLITS = [ATTN_WIDTH, ATTN_WIDTH + KV_WIDTH, ATTN_WIDTH + 2 * KV_WIDTH,
             ATTN_WIDTH + 2 * KV_WIDTH + RWKV_IN_WIDTH]
RW_SPLITS = [RWKV_WIDTH, 2 * RWKV_WIDTH, 3 * RWKV_WIDTH,
             3 * RWKV_WIDTH + DECAY_LORA, 3 * RWKV_WIDTH + DECAY_LORA + ICLR_LORA]

kernel_name = "hybrid_gqa_rwkv7_dit_block"


def rmsnorm(x, g):
    xf = x.astype(jnp.float32)
    y = xf * lax.rsqrt(jnp.mean(xf * xf, axis=-1, keepdims=True) + NORM_EPS)
    return (y * g.astype(jnp.float32)).astype(x.dtype)


def modulate(h, shift, scale):
    return h * (1 + scale) + shift


def axial_rope_tables(rows):
    n_freq = HEAD_DIM // 4
    inv_freq = jnp.power(ROPE_BASE, -jnp.arange(n_freq, dtype=jnp.float32) / n_freq)
    row = jnp.repeat(jnp.arange(rows, dtype=jnp.float32), GRID_W)
    col = jnp.tile(jnp.arange(GRID_W, dtype=jnp.float32), rows)
    ang = jnp.concatenate([row[:, None] * inv_freq, col[:, None] * inv_freq], axis=-1)
    return jnp.cos(ang), jnp.sin(ang)


def apply_rope(x, cos, sin):
    half = x.shape[-1] // 2
    x1, x2 = x[..., :half], x[..., half:]
    c = cos[:, None, :].astype(x.dtype)
    s = sin[:, None, :].astype(x.dtype)
    return jnp.concatenate([x1 * c - x2 * s, x1 * s + x2 * c], axis=-1)


def sink_column(sink, lead_shape):
    s = sink.astype(jnp.float32).reshape(N_KV_HEADS, Q_PER_KV)
    return jnp.broadcast_to(s[:, :, None, None], lead_shape + (1,))


def latent_window_attention(q, k, v, kc, vc, sink):
    B, L, _, dh = q.shape
    Lc = kc.shape[1]
    nb = L // BLOCK
    scale = dh ** -0.5
    qb = q.reshape(B, nb, BLOCK, N_KV_HEADS, Q_PER_KV, dh)
    pad = ((0, 0), (BLOCK, BLOCK), (0, 0), (0, 0))

    def band(t):
        tb = jnp.pad(t, pad).reshape(B, nb + 2, BLOCK, N_KV_HEADS, dh)
        return jnp.concatenate([tb[:, :-2], tb[:, 1:-1], tb[:, 2:]], axis=2)

    kb, vb = band(k), band(v)
    s_loc = jnp.einsum('bnqgrd,bnkgd->bngrqk', qb, kb).astype(jnp.float32) * scale
    s_ctx = jnp.einsum('bnqgrd,bcgd->bngrqc', qb, kc).astype(jnp.float32) * scale
    blk = jnp.arange(nb)[:, None, None]
    qi = jnp.arange(BLOCK)[None, :, None]
    kj = jnp.arange(3 * BLOCK)[None, None, :]
    i_pos = blk * BLOCK + qi
    j_pos = blk * BLOCK - BLOCK + kj
    valid = (jnp.abs(i_pos - j_pos) <= WINDOW) & (j_pos >= 0) & (j_pos < L)
    s_loc = jnp.where(valid[None, :, None, None], s_loc, -jnp.inf)
    s_sink = jnp.broadcast_to(sink.astype(jnp.float32).reshape(N_KV_HEADS, Q_PER_KV)[None, None, :, :, None, None],
                              s_loc.shape[:-1] + (1,))
    p = jax.nn.softmax(jnp.concatenate([s_loc, s_ctx, s_sink], axis=-1), axis=-1)
    p_loc = p[..., :3 * BLOCK].astype(v.dtype)
    p_ctx = p[..., 3 * BLOCK:3 * BLOCK + Lc].astype(v.dtype)
    o = (jnp.einsum('bngrqk,bnkgd->bnqgrd', p_loc, vb)
         + jnp.einsum('bngrqc,bcgd->bnqgrd', p_ctx, vc))
    return o.reshape(B, L, N_Q_HEADS * dh)


def context_attention(qc, kc, vc, sink):
    B, Lc, _, dh = qc.shape
    qg = qc.reshape(B, Lc, N_KV_HEADS, Q_PER_KV, dh)
    s = jnp.einsum('bqgrd,bkgd->bgrqk', qg, kc).astype(jnp.float32) * dh ** -0.5
    s_sink = sink_column(sink, s.shape[1:-1])[None]
    s_sink = jnp.broadcast_to(s_sink, s.shape[:-1] + (1,))
    p = jax.nn.softmax(jnp.concatenate([s, s_sink], axis=-1), axis=-1)
    o = jnp.einsum('bgrqk,bkgd->bqgrd', p[..., :Lc].astype(vc.dtype), vc)
    return o.reshape(B, Lc, N_Q_HEADS * dh)


def short_conv(u, w):
    L = u.shape[1]
    half = SHORT_CONV // 2
    up = jnp.pad(u, ((0, 0), (half, half), (0, 0)))
    return sum(up[:, t:t + L] * w[t] for t in range(SHORT_CONV))


def rwkv_prepare(u, decay_w0, decay_w2, iclr_a0, iclr_a2, k_k, k_a):
    B, L, _ = u.shape
    r, k, v, hw, ha, hg = jnp.split(u, RW_SPLITS, axis=-1)

    def heads(t):
        return t.astype(jnp.float32).reshape(B, L, RWKV_HEADS, RWKV_HEAD_DIM)

    kk = heads(k * k_k)
    kk = kk * lax.rsqrt(jnp.maximum(jnp.sum(kk * kk, axis=-1, keepdims=True), 1e-24))
    dirs = []
    for d in range(2):
        w_log = -jax.nn.softplus(-(decay_w0[d] + jnp.tanh(hw) @ decay_w2[d])) - 0.5
        a = jax.nn.sigmoid(iclr_a0[d] + ha @ iclr_a2[d])
        decay = jnp.exp(-jnp.exp(heads(w_log)))
        k_d = heads(k * (1 + (a - 1) * k_a))
        dirs.append((decay, kk * heads(a), k_d))
    return heads(r), heads(v), hg, kk, dirs


def wkv7_scan(S0, r, decay, kk, b, k, v, reverse, emit):
    xs = tuple(jnp.moveaxis(t, 1, 0) for t in (r, decay, kk, b, k, v))

    def step(S, inp):
        r_t, w_t, kk_t, b_t, k_t, v_t = inp
        sa = jnp.einsum('bhvk,bhk->bhv', S, -kk_t)
        S = S * w_t[:, :, None, :] + sa[..., None] * b_t[:, :, None, :] + v_t[..., None] * k_t[:, :, None, :]
        y = jnp.einsum('bhvk,bhk->bhv', S, r_t) if emit else None
        return S, y

    S, ys = lax.scan(step, S0, xs, reverse=reverse)
    return S, (jnp.moveaxis(ys, 0, 1) if emit else None)


def rwkv_output(y, r, v, hg, dirs, gate_g2, r_k, lnx_w, lnx_b):
    B, L = y.shape[:2]
    mu = jnp.mean(y, axis=-1, keepdims=True)
    var = jnp.mean(jnp.square(y - mu), axis=-1, keepdims=True)
    yn = (y - mu) * lax.rsqrt(var + LNX_EPS)
    k_sum = dirs[0][2] + dirs[1][2]
    bonus = jnp.sum(r * k_sum * r_k.astype(jnp.float32), axis=-1, keepdims=True) * v
    out = (yn.reshape(B, L, RWKV_WIDTH) * lnx_w + lnx_b + bonus.reshape(B, L, RWKV_WIDTH)).astype(hg.dtype)
    g = jax.nn.sigmoid(hg) @ gate_g2
    return out * g


def merge_branches(ya, yr, gate_logits, w_branch_attn, w_branch_rwkv, w_out):
    ga, gr = jnp.split(jax.nn.sigmoid(gate_logits), N_BRANCHES, axis=-1)
    return (ga * (ya @ w_branch_attn) + gr * (yr @ w_branch_rwkv)) @ w_out


def sq_relu_mlp(h, w_up, w_down):
    return jnp.square(jax.nn.relu(h @ w_up)) @ w_down


def trunk_layer(x, xc, c, c_ctx, cos, sin, w_ada, b_ada, norm1_g, w_in, sink, conv_w,
                decay_w0, decay_w2, iclr_a0, iclr_a2, gate_g2, k_k, k_a, r_k, lnx_w, lnx_b,
                w_branch_attn, w_branch_rwkv, w_out, norm2_g, w_mlp_up, w_mlp_down, update_ctx):
    B, L, D = x.shape
    Lc = xc.shape[1]
    mod = (jax.nn.silu(c) @ w_ada + b_ada).reshape(B, 1, N_MOD, D)
    shift1, scale1, gate1, shift2, scale2, gate2 = [mod[:, :, i] for i in range(N_MOD)]
    modc = (jax.nn.silu(c_ctx) @ w_ada + b_ada).reshape(N_MOD, D)

    h = modulate(rmsnorm(x, norm1_g), shift1, scale1)
    hc = modulate(rmsnorm(xc, norm1_g), modc[0], modc[1])
    q, k, v, rw, gl = jnp.split(h @ w_in, IN_SPLITS, axis=-1)
    qc, kc, vc, rwc, glc = jnp.split(hc @ w_in, IN_SPLITS, axis=-1)

    q = apply_rope(q.reshape(B, L, N_Q_HEADS, HEAD_DIM), cos, sin)
    k = apply_rope(k.reshape(B, L, N_KV_HEADS, HEAD_DIM), cos, sin)
    v = v.reshape(B, L, N_KV_HEADS, HEAD_DIM)
    kc = kc.reshape(B, Lc, N_KV_HEADS, HEAD_DIM)
    vc = vc.reshape(B, Lc, N_KV_HEADS, HEAD_DIM)
    ya = latent_window_attention(q, k, v, kc, vc, sink)

    r_l, v_l, hg_l, kk_l, dirs_l = rwkv_prepare(short_conv(rw, conv_w), decay_w0, decay_w2,
                                               iclr_a0, iclr_a2, k_k, k_a)
    r_c, v_c, hg_c, kk_c, dirs_c = rwkv_prepare(short_conv(rwc, conv_w), decay_w0, decay_w2,
                                               iclr_a0, iclr_a2, k_k, k_a)
    S0 = jnp.zeros((B, RWKV_HEADS, RWKV_HEAD_DIM, RWKV_HEAD_DIM), jnp.float32)
    y_lat = []
    y_ctx = []
    for d, rev in enumerate((False, True)):
        dec_c, b_c, k_c = dirs_c[d]
        S_ctx, yc_d = wkv7_scan(S0, r_c, dec_c, kk_c, b_c, k_c, v_c, rev, update_ctx)
        dec_l, b_l, k_l = dirs_l[d]
        _, y_d = wkv7_scan(S_ctx, r_l, dec_l, kk_l, b_l, k_l, v_l, rev, True)
        y_lat.append(y_d)
        y_ctx.append(yc_d)
    yr = rwkv_output(y_lat[0] + y_lat[1], r_l, v_l, hg_l, dirs_l, gate_g2, r_k, lnx_w, lnx_b)

    x = x + gate1 * merge_branches(ya, yr, gl, w_branch_attn, w_branch_rwkv, w_out)
    x = x + gate2 * sq_relu_mlp(modulate(rmsnorm(x, norm2_g), shift2, scale2), w_mlp_up, w_mlp_down)

    if update_ctx:
        yac = context_attention(qc.reshape(B, Lc, N_Q_HEADS, HEAD_DIM), kc, vc, sink)
        yrc = rwkv_output(y_ctx[0] + y_ctx[1], r_c, v_c, hg_c, dirs_c, gate_g2, r_k, lnx_w, lnx_b)
        xc = xc + modc[2] * merge_branches(yac, yrc, glc, w_branch_attn, w_branch_rwkv, w_out)
        xc = xc + modc[5] * sq_relu_mlp(modulate(rmsnorm(xc, norm2_g), modc[3], modc[4]), w_mlp_up, w_mlp_down)
    return x, xc


def setup_inputs(seed: int = 0) -> dict:
    key = jax.random.key(seed)
    ks = iter(jax.random.split(key, 32))

    def nrm(shape, s):
        return jax.random.normal(next(ks), shape, jnp.float32) * s

    D = D_MODEL
    L = DEPTH
    conv_base = jnp.asarray([0.25, 1.0, 0.25], jnp.float32)[None, :, None]
    return {
        "x": nrm((BATCH, SEQ, D), 1.0),
        "c": nrm((BATCH, D), 1.0),
        "ctx": nrm((BATCH, CTX_LEN, D), 1.0),
        "c_ctx": nrm((D,), 1.0),
        "w_ada": nrm((L, D, N_MOD * D), 0.5 * D ** -0.5),
        "b_ada": nrm((L, N_MOD * D), 0.02),
        "norm1_g": 1.0 + nrm((L, D), 0.05),
        "w_in": nrm((L, D, IN_WIDTH), D ** -0.5),
        "sink": nrm((L, N_Q_HEADS), 0.5),
        "conv_w": conv_base + nrm((L, SHORT_CONV, RWKV_IN_WIDTH), 0.05),
        "decay_w0": nrm((L, 2, RWKV_WIDTH), 0.5),
        "decay_w2": nrm((L, 2, DECAY_LORA, RWKV_WIDTH), DECAY_LORA ** -0.5),
        "iclr_a0": nrm((L, 2, RWKV_WIDTH), 0.5),
        "iclr_a2": nrm((L, 2, ICLR_LORA, RWKV_WIDTH), ICLR_LORA ** -0.5),
        "gate_g2": nrm((L, GATE_LORA, RWKV_WIDTH), GATE_LORA ** -0.5),
        "k_k": 1.0 + nrm((L, RWKV_WIDTH), 0.1),
        "k_a": 1.0 + nrm((L, RWKV_WIDTH), 0.1),
        "r_k": nrm((L, RWKV_HEADS, RWKV_HEAD_DIM), 0.1),
        "lnx_w": 1.0 + nrm((L, RWKV_WIDTH), 0.05),
        "lnx_b": nrm((L, RWKV_WIDTH), 0.02),
        "w_branch_attn": nrm((L, ATTN_WIDTH, D), ATTN_WIDTH ** -0.5),
        "w_branch_rwkv": nrm((L, RWKV_WIDTH, D), RWKV_WIDTH ** -0.5),
        "w_out": nrm((L, D, D), D ** -0.5),
        "norm2_g": 1.0 + nrm((L, D), 0.05),
        "w_mlp_up": nrm((L, D, D_FF), D ** -0.5),
        "w_mlp_down": nrm((L, D_FF, D), D_FF ** -0.5),
        "norm_f_g": 1.0 + nrm((D,), 0.05),
    }


def reference(x, c, ctx, c_ctx, w_ada, b_ada, norm1_g, w_in, sink, conv_w, decay_w0, decay_w2,
              iclr_a0, iclr_a2, gate_g2, k_k, k_a, r_k, lnx_w, lnx_b, w_branch_attn, w_branch_rwkv,
              w_out, norm2_g, w_mlp_up, w_mlp_down, norm_f_g):
    rows = x.shape[1] // GRID_W
    cos, sin = axial_rope_tables(rows)
    xc = ctx
    for l in range(DEPTH):
        x, xc = trunk_layer(x, xc, c, c_ctx, cos, sin, w_ada[l], b_ada[l], norm1_g[l], w_in[l], sink[l],
                            conv_w[l], decay_w0[l], decay_w2[l], iclr_a0[l], iclr_a2[l], gate_g2[l],
                            k_k[l], k_a[l], r_k[l], lnx_w[l], lnx_b[l], w_branch_attn[l], w_branch_rwkv[l],
                            w_out[l], norm2_g[l], w_mlp_up[l], w_mlp_down[l], update_ctx=(l < DEPTH - 1))
    return rmsnorm(x, norm_f_g)
```

```cpp
#include <hip/hip_runtime.h>
#include <cstdio>
#include <cstdint>

#ifndef MK_N_LAUNCHES
#define MK_N_LAUNCHES 1
#endif
constexpr int N_PHASES = 12;
constexpr int N_LAUNCHES = MK_N_LAUNCHES;

constexpr int NB = 4, SEQ = 4096, LCX = 256, DM = 1024, FF = 4096;
constexpr int ML = NB * SEQ;
constexpr int MC = NB * LCX;
constexpr int MT = ML + MC;
constexpr int NIN = 4608;
constexpr int RWP = 1792;
constexpr int RWW = 1696;
constexpr int NHR = 8;
constexpr float NORM_EPS = 1e-6f, LNX_EPS = 64e-5f;
constexpr float QSCALE = 0.125f * 1.4426950408889634f;
constexpr float LOG2E = 1.4426950408889634f;

constexpr size_t MiB = 1u << 20;
constexpr size_t WS_CTL = 0, CTL_ZERO_BYTES = 1 * MiB;
constexpr size_t WS_MOD = 1 * MiB;
constexpr size_t WS_CB = 1 * MiB + 256 * 1024;
constexpr size_t WS_WLORA = 1 * MiB + 512 * 1024;
constexpr size_t WS_ROPE = 2 * MiB;
constexpr size_t WS_SS1 = 3 * MiB;
constexpr size_t WS_SS2 = 4 * MiB;
constexpr size_t WS_HGS = 5 * MiB;
constexpr size_t WS_WA = 8 * MiB, WS_WR = 9 * MiB, WS_WO = 10 * MiB, WS_WU = 12 * MiB, WS_WD = 20 * MiB, WS_WIN = 28 * MiB;
constexpr size_t WS_RW = 40 * MiB;
constexpr size_t WS_Z0 = 40 * MiB;
constexpr size_t WS_YRW = 72 * MiB;
constexpr size_t WS_YA = 100 * MiB;
constexpr size_t WS_HB = 116 * MiB;
constexpr size_t WS_Q = 150 * MiB;
constexpr size_t WS_K = 166 * MiB;
constexpr size_t WS_V = 171 * MiB;
constexpr size_t WS_R1L = 116 * MiB;
constexpr size_t WS_R1C = 244 * MiB;
constexpr size_t WS_M1 = 168 * MiB;
constexpr size_t WS_A2 = 200 * MiB;
constexpr size_t WS_U = 40 * MiB;
constexpr size_t WS_END = 256 * MiB;
static_assert(WS_R1L + (size_t)2048 * 65536 <= WS_R1C && WS_R1C + (size_t)128 * 32768 <= WS_END && WS_Z0 + (size_t)64 * 64 * 8192 <= WS_YRW, "rwkv tiles fit");
static_assert(WS_RW + (size_t)MT * RWP * 2 <= WS_YA && WS_YA + (size_t)ML * 512 * 2 <= WS_HB, "map");
static_assert(WS_HB + (size_t)MT * DM * 2 <= WS_Q && WS_K + (size_t)MT * 128 * 2 <= WS_V, "map");
static_assert(WS_U + (size_t)ML * FF * 2 <= WS_M1 && WS_M1 + (size_t)ML * DM * 2 <= WS_A2 && WS_A2 + (size_t)ML * DM * 2 <= WS_END, "map");

constexpr int RING_BYTES = 131072;
constexpr int LDSCTL_OFF = RING_BYTES, MISC_OFF = LDSCTL_OFF + 320;
constexpr int LDS_BYTES = 163840;

#define GAS __attribute__((address_space(1)))
#define LAS __attribute__((address_space(3)))
typedef unsigned short bf16;
typedef unsigned v4u __attribute__((ext_vector_type(4)));
typedef unsigned v2u __attribute__((ext_vector_type(2)));
typedef float f32x4 __attribute__((ext_vector_type(4)));
typedef float f32x2 __attribute__((ext_vector_type(2)));
typedef float f32x16 __attribute__((ext_vector_type(16)));
typedef short bf16x8 __attribute__((ext_vector_type(8)));
typedef GAS unsigned gu32;
typedef GAS unsigned long long gu64;
#define RLX_AGENT __ATOMIC_RELAXED, __HIP_MEMORY_SCOPE_AGENT
#define LDS_WAIT() asm volatile("s_waitcnt lgkmcnt(0)" ::: "memory")
#define VM_WAIT() asm volatile("s_waitcnt vmcnt(0)" ::: "memory")

__device__ __forceinline__ unsigned f2bf(float f) { unsigned u = __builtin_bit_cast(unsigned, f); return (u + 0x7fffu + ((u >> 16) & 1u)) >> 16; }
__device__ __forceinline__ unsigned pk2(float lo, float hi) { return f2bf(lo) | (f2bf(hi) << 16); }
__device__ __forceinline__ float bf_lo(unsigned w) { return __builtin_bit_cast(float, w << 16); }
__device__ __forceinline__ float bf_hi(unsigned w) { return __builtin_bit_cast(float, w & 0xffff0000u); }
__device__ __forceinline__ float bf2f(bf16 h) { return __builtin_bit_cast(float, (unsigned)h << 16); }
__device__ __forceinline__ float fast_rcp(float x) { return __builtin_amdgcn_rcpf(x); }
__device__ __forceinline__ float fast_exp(float x) { return __builtin_amdgcn_exp2f(x * LOG2E); }
__device__ __forceinline__ float sigmoidf_(float x) { return fast_rcp(1.0f + fast_exp(-x)); }
template <int CTRL> __device__ __forceinline__ float dppf(float v) { return __builtin_bit_cast(float, __builtin_amdgcn_update_dpp(0, __builtin_bit_cast(int, v), CTRL, 0xf, 0xf, true)); }
__device__ __forceinline__ float red16(float x) {
    x += dppf<0xB1>(x); x += dppf<0x4E>(x); x += dppf<0x141>(x); x += dppf<0x140>(x); return x; }
__device__ __forceinline__ float rdlane(float v, int l) { return __builtin_bit_cast(float, __builtin_amdgcn_readlane(__builtin_bit_cast(int, v), l)); }
__device__ __forceinline__ float wave_sum(float x) { x = red16(x); return (rdlane(x, 0) + rdlane(x, 16)) + (rdlane(x, 32) + rdlane(x, 48)); }
namespace pg8 {
#define PG8_LAS __attribute__((address_space(3)))
typedef unsigned short bf16_t;
typedef short bf16x8 __attribute__((ext_vector_type(8)));
typedef float f32x4 __attribute__((ext_vector_type(4)));
typedef unsigned u32x4 __attribute__((ext_vector_type(4)));
constexpr int BM = 256, BK = 64, HALF = 128, HTB = HALF * BK * 2  , STAGE_BYTES = 8 * HTB, NXCD = 8, WGM = 8;

__host__ __device__ __forceinline__ int lds_byte(int r, int c) { const int st = (r >> 4) * 2 + (c >> 5), rr = r & 15, cc = c & 31, ob = rr * 64 + cc * 2; return st * 1024 + (ob ^ (((ob >> 9) & 1) << 5)); }
__host__ __device__ __forceinline__ void stage_rc(int b, int& R, int& C) { const int st = b / 1024, sb = b % 1024, swz = sb ^ (((sb >> 9) & 1) << 5); R = (st >> 1) * 16 + swz / 64; C = (st & 1) * 32 + (swz % 64) / 2; }
__host__ __device__ __forceinline__ int perm32(int rho) { const int n = rho >> 4, i = rho & 15; return 8 * (i >> 2) + 4 * n + (i & 3); }

struct Unit { int pm, pn; };
struct Gemm { const bf16_t* A; const bf16_t* Bt; int M, N, K; };

struct StaticOrder {
    int nM, nN, nwg, G, c;
    __host__ __device__ void init(int M, int N, int G_, int c_) { nM = M / BM; nN = N / BM; nwg = nM * nN; G = G_; c = c_; }
    __host__ __device__ bool next(int i, Unit& u) const {
        const long L = (long)i * G + c; if (L >= nwg) return false;
        int wgid = (int)L; { const int q = nwg / NXCD, r = nwg % NXCD, xcd = wgid % NXCD, off = wgid / NXCD; wgid = (xcd < r ? xcd * (q + 1) : r * (q + 1) + (xcd - r) * q) + off; }
        const int nig = WGM * nN, gid = wgid / nig, fm = gid * WGM, gsz = (nM - fm) < WGM ? (nM - fm) : WGM;
        u.pm = fm + ((wgid % nig) % gsz); u.pn = (wgid % nig) / gsz; return true;
    }
    __device__ __forceinline__ void a_ready(const Unit&) const {}
    __device__ __forceinline__ void done(const Unit&) const {}
};

typedef unsigned u32x2 __attribute__((ext_vector_type(2)));

struct OrderX {
    int nM, nN, nwg, G, c, nextra, ex_pm0, ex_npm, ex_pn0;
    __device__ void init(int M, int N, int G_, int c_, int nextra_ = 0, int ex_pm0_ = 0, int ex_npm_ = 1, int ex_pn0_ = 0) {
        nM = M / BM; nN = N / BM; nwg = nM * nN; G = G_; c = c_; nextra = nextra_; ex_pm0 = ex_pm0_; ex_npm = ex_npm_; ex_pn0 = ex_pn0_; }
    __device__ bool next(int i, Unit& u) const {
        const long L = (long)i * G + c; if (L >= nwg + nextra) return false;
        if (L >= nwg) { const int e = (int)L - nwg; u.pm = ex_pm0 + e % ex_npm; u.pn = ex_pn0 + e / ex_npm; return true; }
        int wgid = (int)L; { const int q = nwg / NXCD, r = nwg % NXCD, xcd = wgid % NXCD, off = wgid / NXCD; wgid = (xcd < r ? xcd * (q + 1) : r * (q + 1) + (xcd - r) * q) + off; }
        const int nig = WGM * nN, gid = wgid / nig, fm = gid * WGM, gsz = (nM - fm) < WGM ? (nM - fm) : WGM;
        u.pm = fm + ((wgid % nig) % gsz); u.pn = (wgid % nig) / gsz; return true;
    }
    __device__ __forceinline__ void a_ready(const Unit&) const {}
    __device__ __forceinline__ void done(const Unit&) const {}
};

typedef float cv_f32x2 __attribute__((ext_vector_type(2))); typedef __bf16 cv_bf16x2 __attribute__((ext_vector_type(2)));
__device__ __forceinline__ unsigned cvt_pk_bf16(float lo, float hi) { cv_f32x2 v = {lo, hi}; cv_bf16x2 b = __builtin_convertvector(v, cv_bf16x2); return __builtin_bit_cast(unsigned, b); }
__device__ __forceinline__ float e_rcp(float x) { return __builtin_amdgcn_rcpf(x); }
__device__ __forceinline__ float e_sigmoid(float x) { return e_rcp(1.0f + __builtin_amdgcn_exp2f(x * -1.4426950408889634f)); }
__device__ __forceinline__ float e_lo(unsigned w) { return __builtin_bit_cast(float, w << 16); }
__device__ __forceinline__ float e_hi(unsigned w) { return __builtin_bit_cast(float, w & 0xffff0000u); }

struct EpiInProj {
    static constexpr bool PERM = true, AFTER_DRAIN = false;
    bf16_t *Q, *Kb, *Vb, *RW, *GATE; const float *COS, *SIN; float qscale;
    __device__ __forceinline__ void operator()(const f32x4 (&acc)[2][2][4][2], const Unit& u, int wr, int wc, int fr, int fq) const {
        const int row0 = u.pm * BM + wr * 64 + fr;
#pragma unroll
        for (int bj = 0; bj < 2; ++bj) {
            const int c0 = u.pn * BM + bj * HALF + wc * 32 + 8 * fq;
#pragma unroll
            for (int ai = 0; ai < 2; ++ai)
#pragma unroll
                for (int m = 0; m < 4; ++m) {
                    const int r = row0 + ai * HALF + m * 16;
                    f32x4 v0 = acc[ai][bj][m][0], v1 = acc[ai][bj][m][1];
                    u32x4 w;
                    if (c0 < 640) {
                        if (r < 16384) {
                            const int pos = r & 4095, ip = (c0 & 63) >> 1;
                            const f32x4 cs = *(const f32x4*)(COS + pos * 32 + ip), sn = *(const f32x4*)(SIN + pos * 32 + ip);
                            const f32x4 a = v0, b = v1;
                            v0[0] = a[0] * cs[0] - a[1] * sn[0]; v0[1] = a[0] * sn[0] + a[1] * cs[0];
                            v0[2] = a[2] * cs[1] - a[3] * sn[1]; v0[3] = a[2] * sn[1] + a[3] * cs[1];
                            v1[0] = b[0] * cs[2] - b[1] * sn[2]; v1[1] = b[0] * sn[2] + b[1] * cs[2];
                            v1[2] = b[2] * cs[3] - b[3] * sn[3]; v1[3] = b[2] * sn[3] + b[3] * cs[3];
                        }
                        if (c0 < 512) { v0 = v0 * qscale; v1 = v1 * qscale; }
                        w.x = cvt_pk_bf16(v0[0], v0[1]); w.y = cvt_pk_bf16(v0[2], v0[3]); w.z = cvt_pk_bf16(v1[0], v1[1]); w.w = cvt_pk_bf16(v1[2], v1[3]);
                        if (c0 < 512) *(u32x4*)(Q + (size_t)r * 512 + c0) = w;
                        else *(u32x4*)(Kb + (size_t)r * 128 + (c0 - 512)) = w;
                    } else if (c0 < 768) {
                        w.x = cvt_pk_bf16(v0[0], v0[1]); w.y = cvt_pk_bf16(v0[2], v0[3]); w.z = cvt_pk_bf16(v1[0], v1[1]); w.w = cvt_pk_bf16(v1[2], v1[3]);
                        *(u32x4*)(Vb + (size_t)r * 128 + (c0 - 640)) = w;
                    } else if (c0 < 2560) {
                        w.x = cvt_pk_bf16(v0[0], v0[1]); w.y = cvt_pk_bf16(v0[2], v0[3]); w.z = cvt_pk_bf16(v1[0], v1[1]); w.w = cvt_pk_bf16(v1[2], v1[3]);
                        *(u32x4*)(RW + (size_t)r * 1792 + (c0 - 768)) = w;
                    } else {
                        w.x = cvt_pk_bf16(e_sigmoid(v0[0]), e_sigmoid(v0[1])); w.y = cvt_pk_bf16(e_sigmoid(v0[2]), e_sigmoid(v0[3]));
                        w.z = cvt_pk_bf16(e_sigmoid(v1[0]), e_sigmoid(v1[1])); w.w = cvt_pk_bf16(e_sigmoid(v1[2]), e_sigmoid(v1[3]));
                        *(u32x4*)(GATE + (size_t)r * 2048 + (c0 - 2560)) = w;
                    }
                }
        }
    }
};

template <int MODE> struct EpiBranch {
    static constexpr bool PERM = true, AFTER_DRAIN = false;
    bf16_t* GATE; bf16_t* M1;
    __device__ __forceinline__ void operator()(const f32x4 (&acc)[2][2][4][2], const Unit& u, int wr, int wc, int fr, int fq) const {
        const int row0 = u.pm * BM + wr * 64 + fr;
#pragma unroll
        for (int ai = 0; ai < 2; ++ai)
#pragma unroll
            for (int m = 0; m < 4; ++m) {
                const int r = row0 + ai * HALF + m * 16;
#pragma unroll
                for (int bj = 0; bj < 2; ++bj) {
                    const int c0 = u.pn * BM + bj * HALF + wc * 32 + 8 * fq;
                    const f32x4 v0 = acc[ai][bj][m][0], v1 = acc[ai][bj][m][1];
                    bf16_t* gp = GATE + (size_t)r * 2048 + c0;
                    u32x4 w;
                    if (MODE == 0) {
                        const u32x4 g = *(const u32x4*)gp;
                        w.x = cvt_pk_bf16(e_lo(g.x) * v0[0], e_hi(g.x) * v0[1]); w.y = cvt_pk_bf16(e_lo(g.y) * v0[2], e_hi(g.y) * v0[3]);
                        w.z = cvt_pk_bf16(e_lo(g.z) * v1[0], e_hi(g.z) * v1[1]); w.w = cvt_pk_bf16(e_lo(g.w) * v1[2], e_hi(g.w) * v1[3]);
                        *(u32x4*)gp = w;
                    } else {
                        const u32x4 t = *(const u32x4*)gp; const u32x4 g = *(const u32x4*)(gp + 1024);
                        w.x = cvt_pk_bf16(e_lo(t.x) + e_lo(g.x) * v0[0], e_hi(t.x) + e_hi(g.x) * v0[1]); w.y = cvt_pk_bf16(e_lo(t.y) + e_lo(g.y) * v0[2], e_hi(t.y) + e_hi(g.y) * v0[3]);
                        w.z = cvt_pk_bf16(e_lo(t.z) + e_lo(g.z) * v1[0], e_hi(t.z) + e_hi(g.z) * v1[1]); w.w = cvt_pk_bf16(e_lo(t.w) + e_lo(g.w) * v1[2], e_hi(t.w) + e_hi(g.w) * v1[3]);
                        *(u32x4*)(M1 + (size_t)r * 1024 + c0) = w;
                    }
                }
            }
    }
};

template <int MODE> struct EpiResid {
    static constexpr bool PERM = false, AFTER_DRAIN = false;
    const float* XIN; float* X1; bf16_t* A2; const float* MOD; const float* g2; float* SS; int gate_off;
    __device__ __forceinline__ void operator()(const f32x4 (&acc)[2][2][4][2], const Unit& u, int wr, int wc, int fr, int fq) const {
        const int row0 = u.pm * BM + wr * 64 + fr;
        const int b = (u.pm * BM) >> 12;
        const float* modb = MOD + b * 6144;
        const int colw = u.pn * BM + wc * 32 + 4 * fq;
        f32x4 gt[2][2], gc[2][2];
#pragma unroll
        for (int bj = 0; bj < 2; ++bj)
#pragma unroll
            for (int n = 0; n < 2; ++n) {
                const int c = colw + bj * HALF + n * 16;
                gt[bj][n] = *(const f32x4*)(modb + gate_off + c);
                if (MODE == 0) { const f32x4 sc = *(const f32x4*)(modb + 4 * 1024 + c); const f32x4 gg = *(const f32x4*)(g2 + c); gc[bj][n] = gg * (sc + 1.0f); }
            }
#pragma unroll
        for (int ai = 0; ai < 2; ++ai)
#pragma unroll
            for (int m = 0; m < 4; ++m) {
                const int r = row0 + ai * HALF + m * 16;
                float ss = 0.f;
#pragma unroll
                for (int bj = 0; bj < 2; ++bj)
#pragma unroll
                    for (int n = 0; n < 2; ++n) {
                        const int c = colw + bj * HALF + n * 16;
                        const f32x4 xi = *(const f32x4*)(XIN + (size_t)r * 1024 + c);
                        const f32x4 x1 = xi + gt[bj][n] * acc[ai][bj][m][n];
                        *(f32x4*)(X1 + (size_t)r * 1024 + c) = x1;
                        ss += (x1[0] * x1[0] + x1[1] * x1[1]) + (x1[2] * x1[2] + x1[3] * x1[3]);
                        if (MODE == 0) { const f32x4 a = x1 * gc[bj][n]; u32x2 w; w.x = cvt_pk_bf16(a[0], a[1]); w.y = cvt_pk_bf16(a[2], a[3]); *(u32x2*)(A2 + (size_t)r * 1024 + c) = w; }
                    }
                ss += __shfl_xor(ss, 16); ss += __shfl_xor(ss, 32);
                if (fq == 0) SS[(size_t)(u.pn * 4 + wc) * 16384 + r] = ss;
            }
    }
};

struct EpiUp {
    static constexpr bool PERM = true, AFTER_DRAIN = false;
    bf16_t* U; const float* SS; const float* CB;
    __device__ __forceinline__ void operator()(const f32x4 (&acc)[2][2][4][2], const Unit& u, int wr, int wc, int fr, int fq) const {
        const int row0 = u.pm * BM + wr * 64 + fr;
        const int b = (u.pm * BM) >> 12;
        f32x4 cb[2][2];
#pragma unroll
        for (int bj = 0; bj < 2; ++bj)
#pragma unroll
            for (int n = 0; n < 2; ++n) cb[bj][n] = *(const f32x4*)(CB + b * 4096 + u.pn * BM + bj * HALF + wc * 32 + 8 * fq + 4 * n);
#pragma unroll
        for (int ai = 0; ai < 2; ++ai)
#pragma unroll
            for (int m = 0; m < 4; ++m) {
                const int r = row0 + ai * HALF + m * 16;
                float s = 0.f;
#pragma unroll
                for (int p = 0; p < 16; ++p) s += SS[(size_t)p * 16384 + r];
                const float rs = __builtin_amdgcn_rsqf(s * (1.0f / 1024.0f) + 1e-6f);
#pragma unroll
                for (int bj = 0; bj < 2; ++bj) {
                    const int c0 = u.pn * BM + bj * HALF + wc * 32 + 8 * fq;
                    f32x4 v0 = acc[ai][bj][m][0] * rs + cb[bj][0], v1 = acc[ai][bj][m][1] * rs + cb[bj][1];
#pragma unroll
                    for (int e = 0; e < 4; ++e) { const float a = v0[e] > 0.f ? v0[e] : 0.f; v0[e] = a * a; const float c = v1[e] > 0.f ? v1[e] : 0.f; v1[e] = c * c; }
                    u32x4 w; w.x = cvt_pk_bf16(v0[0], v0[1]); w.y = cvt_pk_bf16(v0[2], v0[3]); w.z = cvt_pk_bf16(v1[0], v1[1]); w.w = cvt_pk_bf16(v1[2], v1[3]);
                    *(u32x4*)(U + (size_t)r * 4096 + c0) = w;
                }
            }
    }
};
template <class Epi, class Sched, bool ALIGN_EPI = false, bool SP2 = false>
__device__ __forceinline__ void gemm_phase(PG8_LAS unsigned char* lds, const Gemm g, const Sched& S, const Epi& E) {
    const int tid = threadIdx.x, wid = __builtin_amdgcn_readfirstlane(tid >> 6), lane = tid & 63, wr = wid >> 2, wc = wid & 3, fr = lane & 15, fq = lane >> 4;
    const int K = g.K, nt = K / BK;
    unsigned voffA[2], voffB[2];
#pragma unroll
    for (int i = 0; i < 2; ++i) { int R, C; stage_rc(tid * 16 + i * 8192, R, C); const int Rb = Epi::PERM ? ((R & ~31) + perm32(R & 31)) : R;
        voffA[i] = (unsigned)(R * K + C) * 2u; voffB[i] = (unsigned)(Rb * K + C) * 2u; }
    const size_t kstep = (size_t)(BK * 2);
    const size_t hstep = (size_t)HALF * K * 2;
    const size_t tstep = 2 * hstep;
    const unsigned ldsw = (unsigned)wid * 1024u;
    const int aoff = lds_byte(wr * 64 + fr, fq * 8), boff = lds_byte(wc * 32 + fr, fq * 8);
#define PG8_SA(b, h) (((b) * 2 + (h)) * HTB)
#define PG8_SB(b, h) ((4 + (b) * 2 + (h)) * HTB)
#define PG8_STAGE(bufoff, gbase, voff) do { _Pragma("unroll") for (int _i = 0; _i < 2; ++_i) \
        __builtin_amdgcn_global_load_lds((const unsigned*)((const char*)(gbase) + (voff)[_i]), (PG8_LAS unsigned*)(lds + (bufoff) + ldsw + _i * 8192), 16, 0, 0); } while (0)
#define PG8_LDA(dst, b, h) do { _Pragma("unroll") for (int m = 0; m < 4; ++m) _Pragma("unroll") for (int k = 0; k < 2; ++k) dst[m][k] = *(const PG8_LAS bf16x8*)(lds + PG8_SA(b, h) + aoff + m * 2048 + k * 1024); } while (0)
#define PG8_LDB(dst, b, h) do { _Pragma("unroll") for (int n = 0; n < 2; ++n) _Pragma("unroll") for (int k = 0; k < 2; ++k) dst[n][k] = *(const PG8_LAS bf16x8*)(lds + PG8_SB(b, h) + boff + n * 2048 + k * 1024); } while (0)
#define PG8_MMA(ai, bj, At, Bt) do { __builtin_amdgcn_s_setprio(1); _Pragma("unroll") for (int m = 0; m < 4; ++m) _Pragma("unroll") for (int n = 0; n < 2; ++n) _Pragma("unroll") for (int k = 0; k < 2; ++k) \
        acc[ai][bj][m][n] = __builtin_amdgcn_mfma_f32_16x16x32_bf16(Bt[n][k], At[m][k], acc[ai][bj][m][n], 0, 0, 0); __builtin_amdgcn_s_setprio(0); } while (0)
#define PG8_WAIT_V(n) asm volatile("s_waitcnt vmcnt(" #n ")" ::: "memory")
#define PG8_WAIT_L(n) asm volatile("s_waitcnt lgkmcnt(" #n ")" ::: "memory")
#define PG8_BAR __builtin_amdgcn_s_barrier()
#define PG8_SCHED __builtin_amdgcn_sched_barrier(0)
    Unit cur, nxt; int ui = 0;
    if (!S.next(0, cur)) return;
    f32x4 acc[2][2][4][2];
#pragma unroll
    for (int a = 0; a < 2; ++a)
#pragma unroll
        for (int b = 0; b < 2; ++b)
#pragma unroll
            for (int m = 0; m < 4; ++m)
#pragma unroll
                for (int n = 0; n < 2; ++n) acc[a][b][m][n] = (f32x4){0.f, 0.f, 0.f, 0.f};
    bf16x8 At[4][2], B0[2][2], B1[2][2];
    const char* cA = (const char*)g.A + (size_t)cur.pm * tstep; const char* cB = (const char*)g.Bt + (size_t)cur.pn * tstep;
    S.a_ready(cur);
    if constexpr (SP2) {
        PG8_STAGE(PG8_SB(0, 0), cB, voffB); PG8_STAGE(PG8_SB(0, 1), cB + hstep, voffB); PG8_STAGE(PG8_SA(0, 0), cA, voffA); PG8_STAGE(PG8_SA(0, 1), cA + hstep, voffA);
        if (wr == 1) PG8_BAR;
        PG8_WAIT_V(2); PG8_BAR;
        PG8_STAGE(PG8_SB(1, 0), cB + kstep, voffB); PG8_STAGE(PG8_SA(1, 0), cA + kstep, voffA); PG8_STAGE(PG8_SB(1, 1), cB + hstep + kstep, voffB);
        PG8_WAIT_V(6); PG8_BAR;
    } else {
        PG8_STAGE(PG8_SB(0, 0), cB, voffB); PG8_STAGE(PG8_SA(0, 0), cA, voffA); PG8_STAGE(PG8_SB(0, 1), cB + hstep, voffB); PG8_STAGE(PG8_SA(0, 1), cA + hstep, voffA);
        if (wr == 1) PG8_BAR;
        PG8_WAIT_V(4); PG8_BAR;
        PG8_STAGE(PG8_SB(1, 0), cB + kstep, voffB); PG8_STAGE(PG8_SA(1, 0), cA + kstep, voffA); PG8_STAGE(PG8_SB(1, 1), cB + hstep + kstep, voffB);
        PG8_WAIT_V(6); PG8_BAR;
    }
    for (;;) {
        const bool has_next = S.next(ui + 1, nxt);
        const char* nA = has_next ? (const char*)g.A + (size_t)nxt.pm * tstep : cA; const char* nB = has_next ? (const char*)g.Bt + (size_t)nxt.pn * tstep : cB;
        for (int t = 0; t < nt; t += 2) {
            const bool last = (t == nt - 2);
            const char* a1 = cA + (size_t)(t + 1) * kstep;
            const char* a2 = last ? nA : cA + (size_t)(t + 2) * kstep; const char* b2 = last ? nB : cB + (size_t)(t + 2) * kstep;
            const char* a3 = a2 + kstep; const char* b3 = b2 + kstep;
            if (last && has_next) S.a_ready(nxt);
            if constexpr (SP2) {
            PG8_LDB(B0, 0, 0); PG8_LDB(B1, 0, 1); PG8_SCHED; PG8_LDA(At, 0, 0); PG8_STAGE(PG8_SA(1, 1), a1 + hstep, voffA);
            PG8_WAIT_V(8); PG8_WAIT_L(0); PG8_BAR; PG8_MMA(0, 0, At, B0); PG8_MMA(0, 1, At, B1); PG8_BAR; PG8_SCHED;
            PG8_LDA(At, 0, 1); PG8_STAGE(PG8_SB(0, 0), b2, voffB); PG8_STAGE(PG8_SB(0, 1), b2 + hstep, voffB); PG8_STAGE(PG8_SA(0, 0), a2, voffA);
            PG8_WAIT_V(8); PG8_WAIT_L(0); PG8_BAR; PG8_MMA(1, 0, At, B0); PG8_MMA(1, 1, At, B1); PG8_BAR; PG8_SCHED;
            PG8_LDB(B0, 1, 0); PG8_LDB(B1, 1, 1); PG8_SCHED; PG8_LDA(At, 1, 0); PG8_STAGE(PG8_SA(0, 1), a2 + hstep, voffA);
            PG8_WAIT_V(8); PG8_WAIT_L(0); PG8_BAR; PG8_MMA(0, 0, At, B0); PG8_MMA(0, 1, At, B1); PG8_BAR; PG8_SCHED;
            PG8_LDA(At, 1, 1); PG8_STAGE(PG8_SB(1, 0), b3, voffB); PG8_STAGE(PG8_SB(1, 1), b3 + hstep, voffB); PG8_STAGE(PG8_SA(1, 0), a3, voffA);
            PG8_WAIT_V(8); PG8_WAIT_L(0); PG8_BAR; PG8_MMA(1, 0, At, B0); PG8_MMA(1, 1, At, B1); PG8_BAR; PG8_SCHED;
            } else {
            PG8_LDB(B0, 0, 0); PG8_SCHED; PG8_LDA(At, 0, 0); PG8_STAGE(PG8_SA(1, 1), a1 + hstep, voffA);
            PG8_WAIT_L(8); PG8_BAR; PG8_WAIT_L(0); PG8_MMA(0, 0, At, B0); PG8_BAR; PG8_SCHED;
            PG8_LDB(B1, 0, 1); PG8_STAGE(PG8_SB(0, 0), b2, voffB);
            PG8_BAR; PG8_WAIT_L(0); PG8_MMA(0, 1, At, B1); PG8_BAR;
            PG8_LDA(At, 0, 1); PG8_STAGE(PG8_SA(0, 0), a2, voffA);
            PG8_BAR; PG8_WAIT_L(0); PG8_MMA(1, 0, At, B0); PG8_BAR; PG8_SCHED;
            PG8_STAGE(PG8_SB(0, 1), b2 + hstep, voffB);
            PG8_WAIT_V(6); PG8_BAR; PG8_MMA(1, 1, At, B1); PG8_BAR;
            PG8_LDB(B0, 1, 0); PG8_SCHED; PG8_LDA(At, 1, 0); PG8_STAGE(PG8_SA(0, 1), a2 + hstep, voffA);
            PG8_WAIT_L(8); PG8_BAR; PG8_WAIT_L(0); PG8_MMA(0, 0, At, B0); PG8_BAR; PG8_SCHED;
            PG8_LDB(B1, 1, 1); PG8_STAGE(PG8_SB(1, 0), b3, voffB);
            PG8_BAR; PG8_WAIT_L(0); PG8_MMA(0, 1, At, B1); PG8_BAR;
            PG8_LDA(At, 1, 1); PG8_STAGE(PG8_SA(1, 0), a3, voffA);
            PG8_BAR; PG8_WAIT_L(0); PG8_MMA(1, 0, At, B0); PG8_BAR; PG8_SCHED;
            PG8_STAGE(PG8_SB(1, 1), b3 + hstep, voffB);
            PG8_WAIT_V(6); PG8_BAR; PG8_MMA(1, 1, At, B1); PG8_BAR;
            }
        }
        if constexpr (ALIGN_EPI) { if (wr == 0) PG8_BAR; }
        if constexpr (!Epi::AFTER_DRAIN) { E(acc, cur, wr, wc, fr, fq); S.done(cur); }
        if (!has_next) break;
#pragma unroll
        for (int a = 0; a < 2; ++a)
#pragma unroll
            for (int b = 0; b < 2; ++b)
#pragma unroll
                for (int m = 0; m < 4; ++m)
#pragma unroll
                    for (int n = 0; n < 2; ++n) acc[a][b][m][n] = (f32x4){0.f, 0.f, 0.f, 0.f};
        cur = nxt; cA = nA; cB = nB; ++ui;
        if constexpr (ALIGN_EPI) { if (wr == 1) PG8_BAR; }
    }
    PG8_WAIT_V(0);
    if constexpr (!ALIGN_EPI) { if (wr == 0) PG8_BAR; }
    PG8_BAR;
    if constexpr (Epi::AFTER_DRAIN) { E.fused(acc, cur, wr, wc, fr, fq, lds, wid, lane); S.done(cur); }
#undef PG8_SA
#undef PG8_SB
#undef PG8_STAGE
#undef PG8_LDA
#undef PG8_LDB
#undef PG8_MMA
#undef PG8_WAIT_V
#undef PG8_WAIT_L
#undef PG8_BAR
#undef PG8_SCHED
}
}

namespace att {
typedef short s16x4 __attribute__((ext_vector_type(4)));
typedef short v4i16_t __attribute__((ext_vector_type(4)));
constexpr int SLOTB = 8192;
constexpr int LDS_K = 0, LDS_V = 2 * SLOTB, LDS_WS = 4 * SLOTB, LDS_OST = LDS_WS + 8 * 256, LDS_TOT = LDS_OST + 8 * 4096;
__device__ __forceinline__ int crow(int r, int hi) { return (r & 3) + 8 * (r >> 2) + 4 * hi; }
__device__ __forceinline__ void glds16(const void* gsrc, unsigned lds_dst) { unsigned keep;
    asm volatile("s_mov_b32 %0, m0\n\ts_mov_b32 m0, %2\n\ts_nop 0\n\tglobal_load_lds_dwordx4 %1, off\n\ts_mov_b32 m0, %0" : "=&s"(keep) : "v"(gsrc), "s"(lds_dst) : "memory"); }
#define ATT_WAIT_BAR(N) asm volatile("s_waitcnt vmcnt(" #N ") lgkmcnt(0)\n\ts_barrier" ::: "memory")
typedef float cv_f32x2 __attribute__((ext_vector_type(2))); typedef __bf16 cv_bf16x2 __attribute__((ext_vector_type(2)));
__device__ __forceinline__ unsigned cvtpk(float lo, float hi) { cv_f32x2 v = {lo, hi}; cv_bf16x2 b = __builtin_convertvector(v, cv_bf16x2); return __builtin_bit_cast(unsigned, b); }

__device__ __forceinline__ void attn_unit(int b, int g, int qb, const bf16* Q, const bf16* Kb, const bf16* Vb, bf16* O, const float* sink, LAS unsigned char* shm) {
    const int tid = threadIdx.x, lane = tid & 63, r32 = lane & 31, hi = lane >> 5; const int wid = __builtin_amdgcn_readfirstlane(tid >> 6);
    const int hq = g * 4 + (wid >> 1);
    const int qrel = (wid & 1) * 32 + r32;
    const size_t qrow0 = (size_t)b * 4096 + (size_t)qb * 64 + (wid & 1) * 32;
    const unsigned lds0 = (unsigned)(uintptr_t)shm;
    LAS float* wsf = (LAS float*)(shm + LDS_WS) + wid * 64;
    const int jlo = qb == 0 ? 2 : (qb == 1 ? 1 : 0), jhi = (65 - qb) < 4 ? (65 - qb) : 4, nloc = jhi - jlo + 1, NT = nloc + 4;
    const unsigned kdst = lds0 + LDS_K + wid * 1024, vdst = lds0 + LDS_V + wid * 1024;
    const bf16* kbase = Kb + (size_t)lane * 128 + g * 64 + wid * 8;
    const bf16* vbase = Vb + (size_t)(16 * (wid & 3) + (lane >> 2)) * 128 + g * 64 + (wid >> 2) * 32 + (lane & 3) * 8;
#define ATT_ROWBASE(t) ((t) < nloc ? ((size_t)b * 4096 + (size_t)(64 * (qb + jlo + (t) - 2))) : ((size_t)16384 + (size_t)b * 256 + (size_t)(64 * ((t) - nloc))))
#define ATT_DMA(t, slot) do { const size_t rb_ = ATT_ROWBASE(t); glds16(kbase + rb_ * 128, (unsigned)__builtin_amdgcn_readfirstlane(kdst + (slot) * SLOTB)); \
                              glds16(vbase + rb_ * 128, (unsigned)__builtin_amdgcn_readfirstlane(vdst + (slot) * SLOTB)); } while (0)
    ATT_DMA(0, 0);
    bf16x8 qr[4];
#pragma unroll
    for (int d0 = 0; d0 < 4; ++d0) qr[d0] = *(const bf16x8*)(Q + (qrow0 + r32) * 512 + hq * 64 + d0 * 16 + hi * 8);
    float m_run = sink[hq] * LOG2E, l_reg = hi == 0 ? 1.0f : 0.0f;
    f32x16 o[2]; o[0] = f32x16{}; o[1] = f32x16{};
    const int vb0 = (int)(lds0 + LDS_V) + ((lane >> 4) & 1) * 32 + (lane & 3) * 8 + (4 * hi + ((lane & 15) >> 2)) * 64;
    for (int t = 0; t < NT; ++t) {
        const int slot = t & 1;
        if (t + 1 < NT) { ATT_DMA(t + 1, slot ^ 1); ATT_WAIT_BAR(2); } else { ATT_WAIT_BAR(0); }
        f32x16 p0 = f32x16{}, p1 = f32x16{};
        { const LAS unsigned char* kb = shm + LDS_K + slot * SLOTB + hi * 1024 + r32 * 16;
#pragma unroll
          for (int d0 = 0; d0 < 4; ++d0) {
              const bf16x8 b0 = *(const LAS bf16x8*)(kb + d0 * 2048);
              const bf16x8 b1 = *(const LAS bf16x8*)(kb + d0 * 2048 + 512);
              p0 = __builtin_amdgcn_mfma_f32_32x32x16_bf16(b0, qr[d0], p0, 0, 0, 0);
              p1 = __builtin_amdgcn_mfma_f32_32x32x16_bf16(b1, qr[d0], p1, 0, 0, 0); } }
        const int mode = (t < nloc) ? ((jlo + t) == 0 ? 1 : ((jlo + t) == 4 ? 2 : 0)) : 0;
        if (mode != 0) {
            int q_ = qrel - 4 * hi; asm volatile("" : "+v"(q_));
            if (mode == 1) {
#pragma unroll
                for (int r = 0; r < 16; ++r) { const int kr = (r & 3) + 8 * (r >> 2); if (kr < q_) p0[r] = -INFINITY; if (kr + 32 < q_) p1[r] = -INFINITY; }
            } else {
#pragma unroll
                for (int r = 0; r < 16; ++r) { const int kr = (r & 3) + 8 * (r >> 2); if (kr > q_) p0[r] = -INFINITY; if (kr + 32 > q_) p1[r] = -INFINITY; }
            }
        }
        float rm = fmaxf(p0[0], p1[0]);
#pragma unroll
        for (int r = 1; r < 16; ++r) rm = fmaxf(rm, fmaxf(p0[r], p1[r]));
        { auto rr = __builtin_amdgcn_permlane32_swap(__float_as_uint(rm), __float_as_uint(rm), false, false); rm = fmaxf(__uint_as_float(rr[0]), __uint_as_float(rr[1])); }
        const float mnew = fmaxf(m_run, rm), alpha = __builtin_amdgcn_exp2f(m_run - mnew); m_run = mnew;
        float sacc = 0.f;
#pragma unroll
        for (int r = 0; r < 16; ++r) { p0[r] = __builtin_amdgcn_exp2f(p0[r] - mnew); p1[r] = __builtin_amdgcn_exp2f(p1[r] - mnew); sacc += p0[r] + p1[r]; }
        l_reg = l_reg * alpha + sacc;
        if (hi == 0) wsf[r32] = alpha;
#pragma unroll
        for (int r = 0; r < 16; ++r) { const float f = wsf[crow(r, hi)]; o[0][r] *= f; o[1][r] *= f; }
        v4u pw[4];
#define ATT_PK(P, B) cvtpk(P[B], P[B + 1])
        pw[0] = (v4u){ATT_PK(p0, 0), ATT_PK(p0, 2), ATT_PK(p0, 4), ATT_PK(p0, 6)}; pw[1] = (v4u){ATT_PK(p0, 8), ATT_PK(p0, 10), ATT_PK(p0, 12), ATT_PK(p0, 14)};
        pw[2] = (v4u){ATT_PK(p1, 0), ATT_PK(p1, 2), ATT_PK(p1, 4), ATT_PK(p1, 6)}; pw[3] = (v4u){ATT_PK(p1, 8), ATT_PK(p1, 10), ATT_PK(p1, 12), ATT_PK(p1, 14)};
#undef ATT_PK
        { const int vb = vb0 + slot * SLOTB;
#pragma unroll
          for (int d0 = 0; d0 < 2; ++d0) { s16x4 lo[4], hh[4];
#pragma unroll
              for (int ks = 0; ks < 4; ++ks) {
                  asm volatile("ds_read_b64_tr_b16 %0,%1 offset:%c2" : "=&v"(lo[ks]) : "v"(vb), "i"(d0 * 4096 + ks * 1024) : "memory");
                  asm volatile("ds_read_b64_tr_b16 %0,%1 offset:%c2" : "=&v"(hh[ks]) : "v"(vb), "i"(d0 * 4096 + ks * 1024 + 512) : "memory"); }
              asm volatile("s_waitcnt lgkmcnt(0)" ::: "memory"); __builtin_amdgcn_sched_barrier(0);
#define ATT_VF(k) (bf16x8){lo[k][0], lo[k][1], lo[k][2], lo[k][3], hh[k][0], hh[k][1], hh[k][2], hh[k][3]}
              o[d0] = __builtin_amdgcn_mfma_f32_32x32x16_bf16(__builtin_bit_cast(bf16x8, pw[0]), ATT_VF(0), o[d0], 0, 0, 0);
              o[d0] = __builtin_amdgcn_mfma_f32_32x32x16_bf16(__builtin_bit_cast(bf16x8, pw[1]), ATT_VF(1), o[d0], 0, 0, 0);
              o[d0] = __builtin_amdgcn_mfma_f32_32x32x16_bf16(__builtin_bit_cast(bf16x8, pw[2]), ATT_VF(2), o[d0], 0, 0, 0);
              o[d0] = __builtin_amdgcn_mfma_f32_32x32x16_bf16(__builtin_bit_cast(bf16x8, pw[3]), ATT_VF(3), o[d0], 0, 0, 0);
#undef ATT_VF
          } }
        asm volatile("s_waitcnt lgkmcnt(0)\n\ts_barrier" ::: "memory");
    }
    { auto rr = __builtin_amdgcn_permlane32_swap(__float_as_uint(l_reg), __float_as_uint(l_reg), false, false); l_reg = __uint_as_float(rr[0]) + __uint_as_float(rr[1]); }
    if (hi == 0) wsf[32 + r32] = l_reg;
    float rli[16];
#pragma unroll
    for (int r = 0; r < 16; ++r) rli[r] = __builtin_amdgcn_rcpf(wsf[32 + crow(r, hi)]);
    bf16* Ow = O + qrow0 * 512 + hq * 64;
    { LAS bf16* stg = (LAS bf16*)(shm + LDS_OST) + wid * 2048;
#pragma unroll
      for (int r = 0; r < 16; ++r) { const int orow = crow(r, hi);
#pragma unroll
          for (int d0 = 0; d0 < 2; ++d0) stg[orow * 64 + d0 * 32 + r32] = (bf16)f2bf(o[d0][r] * rli[r]); }
#pragma unroll
      for (int i = 0; i < 4; ++i) { const int row = i * 8 + (lane >> 3), ch = lane & 7; const v4u v = *(const LAS v4u*)(stg + row * 64 + ch * 8); *(v4u*)(Ow + (size_t)row * 512 + ch * 8) = v; } }
    asm volatile("s_waitcnt vmcnt(0) lgkmcnt(0)\n\ts_barrier" ::: "memory");
#undef ATT_DMA
#undef ATT_ROWBASE
}
}
constexpr int CW_BAR = 4096;
#define XB_TMO      128
#define XB_XCNT(j)  (256  + 64 * (j))
#define XB_XSUB(j)  (1280 + 64 * (j))
#define XB_XGEN(j)  (2304 + 64 * (j))
#define XB_TOP      3328
#define XB_TOPGEN   3392
#define XCD_BAR_WORDS 3456
#define XB_SPIN_CAP (1u << 18)

__device__ __forceinline__ unsigned xb_ld(unsigned* p)              { return __hip_atomic_load(p, __ATOMIC_RELAXED, __HIP_MEMORY_SCOPE_AGENT); }
__device__ __forceinline__ unsigned xb_add(unsigned* p, unsigned v) { return __hip_atomic_fetch_add(p, v, __ATOMIC_RELAXED, __HIP_MEMORY_SCOPE_AGENT); }
__device__ __forceinline__ unsigned xb_xcc_id() { return (unsigned)__builtin_amdgcn_s_getreg((3 << 11) | 20) & 0xFu; }
#define XB_SPIN(cond, bar) do { unsigned _sp = 0; while (cond) { __builtin_amdgcn_s_sleep(1); \
    if ((++_sp & 255u) == 0u) { if (xb_ld(&(bar)[XB_TMO])) break; if (_sp > XB_SPIN_CAP) { atomicAdd(&(bar)[XB_TMO], 1u); break; } } } } while (0)

struct XcdBarrier {
    unsigned* bar; unsigned x;
    volatile LAS unsigned* st;
};

__device__ __forceinline__ XcdBarrier xcd_barrier_post(unsigned* bar, volatile LAS unsigned* st) {
    XcdBarrier b; b.bar = bar; b.x = xb_xcc_id(); b.st = st;
    if (threadIdx.x == 0) (void)xb_add(&bar[XB_XCNT(b.x)], 1u);
    return b;
}
__device__ __forceinline__ void xcd_barrier_complete(unsigned* bar, unsigned x, unsigned& nloc, unsigned& nx) {
    const unsigned G = gridDim.x * gridDim.y * gridDim.z;
    unsigned sum, cnt, mine, sp = 0u;
    for (;;) {
        sum = 0u; cnt = 0u; mine = 0u;
#pragma unroll
        for (unsigned j = 0; j < 16; ++j) { const unsigned c = xb_ld(&bar[XB_XCNT(j)]); sum += c; cnt += (c > 0u) ? 1u : 0u; mine = (j == x) ? c : mine; }
        if (sum == G) break;
        __builtin_amdgcn_s_sleep(1);
        if ((++sp & 255u) == 0u) { if (xb_ld(&bar[XB_TMO])) break; if (sp > XB_SPIN_CAP) { atomicAdd(&bar[XB_TMO], 1u); break; } }
    }
    nloc = mine > 0u ? mine : 1u; nx = cnt > 0u ? cnt : 1u;
}

__device__ __forceinline__ void xcd_barrier(const XcdBarrier& b) {
    asm volatile("s_waitcnt vmcnt(0)" ::: "memory");
    __syncthreads();
    if (threadIdx.x == 0) {
        unsigned* bar = b.bar;
        __builtin_amdgcn_s_waitcnt(0);
        unsigned nloc = b.st[0], nx = b.st[1];
        if (nloc == 0u) { xcd_barrier_complete(bar, b.x, nloc, nx); b.st[0] = nloc; b.st[1] = nx; }
        const unsigned old = xb_add(&bar[XB_XSUB(b.x)], 1u);
        const unsigned gen = old / nloc;
        if (old + 1u == (gen + 1u) * nloc) {
            __builtin_amdgcn_fence(__ATOMIC_RELEASE, "agent");
            asm volatile("s_waitcnt vmcnt(0)" ::: "memory");
            const unsigned og = xb_add(&bar[XB_TOP], 1u);
            const unsigned tg = og / nx;
            if (og + 1u == (tg + 1u) * nx) xb_add(&bar[XB_TOPGEN], 1u);
            else XB_SPIN(xb_ld(&bar[XB_TOPGEN]) == tg, bar);
            __builtin_amdgcn_fence(__ATOMIC_ACQUIRE, "agent");
            xb_add(&bar[XB_XGEN(b.x)], 1u);
            asm volatile("s_waitcnt vmcnt(0)" ::: "memory");
        } else {
            XB_SPIN(xb_ld(&bar[XB_XGEN(b.x)]) == gen, bar);
            __builtin_amdgcn_fence(__ATOMIC_ACQUIRE, "agent");
            asm volatile("s_waitcnt vmcnt(0)" ::: "memory");
        }
    }
    __syncthreads();
}

struct Args { const float* in[27]; float* out; unsigned char* ws; int ph_lo, ph_hi, li, pad; };
typedef __attribute__((address_space(4))) const Args* KP;
__device__ __forceinline__ KP kargs_opaque() { KP p_ = (KP)__builtin_amdgcn_kernarg_segment_ptr(); asm volatile("" : "+s"(p_)); return p_; }
__device__ __forceinline__ int opaque_i(int v) { asm volatile("" : "+s"(v)); return v; }
enum { I_X = 0, I_C, I_CTX, I_CCTX, I_WADA, I_BADA, I_N1G, I_WIN, I_SINK, I_CONVW, I_DW0, I_DW2, I_IA0, I_IA2, I_GG2, I_KK, I_KA, I_RK, I_LNXW, I_LNXB, I_WBA, I_WBR, I_WOUT, I_N2G, I_WUP, I_WDN, I_NFG };


namespace rk {
constexpr int TILE = 8192;
__device__ __forceinline__ int toff(int row, int col) { return row * 128 + ((((col >> 3) ^ (row & 7)) << 4) | ((col & 7) << 1)); }
__device__ __forceinline__ bf16x8 ldfrag(const LAS unsigned char* t, int row, int col0) { return *(const LAS bf16x8*)(t + toff(row, col0)); }
__device__ __forceinline__ unsigned pkbf(float lo, float hi) { f32x2 v = {lo, hi}; typedef __bf16 b2 __attribute__((ext_vector_type(2))); b2 b = __builtin_convertvector(v, b2); return __builtin_bit_cast(unsigned, b); }
__device__ __forceinline__ void st_nat(LAS unsigned char* t, int q, int p0, f32x4 d) { v2u w; w.x = pkbf(d[0], d[1]); w.y = pkbf(d[2], d[3]); *(LAS v2u*)(t + toff(q, p0)) = w; }
__device__ __forceinline__ void st_tr(LAS unsigned char* t, int p0, int q, f32x4 d) {
#pragma unroll
    for (int r = 0; r < 4; ++r) *(LAS bf16*)(t + toff(p0 + r, q)) = (bf16)f2bf(d[r]); }
__device__ __forceinline__ void st_gnat(bf16* g, int q, int p0, f32x4 d) { v2u w; w.x = pkbf(d[0], d[1]); w.y = pkbf(d[2], d[3]); *(v2u*)(g + q * 64 + p0) = w; }
#define RK_MFMA(a, b, c) __builtin_amdgcn_mfma_f32_16x16x32_bf16(a, b, c, 0, 0, 0)
#define RK_BAR() asm volatile("s_waitcnt lgkmcnt(0)\n\ts_barrier" ::: "memory")
template <class Epi> __device__ __forceinline__ void mm64(const LAS unsigned char* X, const LAS unsigned char* Y, int wave, int lane, const Epi& epi) {
    const int c = lane & 15, qd = lane >> 4, qt = wave & 3, pt0 = 2 * (wave >> 2);
    const bf16x8 y0 = ldfrag(Y, 16 * qt + c, 8 * qd), y1 = ldfrag(Y, 16 * qt + c, 32 + 8 * qd);
    const bf16x8 xa0 = ldfrag(X, 16 * pt0 + c, 8 * qd), xa1 = ldfrag(X, 16 * pt0 + c, 32 + 8 * qd), xb0 = ldfrag(X, 16 * pt0 + 16 + c, 8 * qd), xb1 = ldfrag(X, 16 * pt0 + 16 + c, 32 + 8 * qd);
    f32x4 da = {0.f, 0.f, 0.f, 0.f}, db = {0.f, 0.f, 0.f, 0.f};
    da = RK_MFMA(xa0, y0, da); db = RK_MFMA(xb0, y0, db); da = RK_MFMA(xa1, y1, da); db = RK_MFMA(xb1, y1, db);
    epi(pt0, qt, da, 16 * pt0 + 4 * qd, 16 * qt + c); epi(pt0 + 1, qt, db, 16 * pt0 + 16 + 4 * qd, 16 * qt + c);
}
template <class Epi> __device__ __forceinline__ void mm64_2(const LAS unsigned char* X1, const LAS unsigned char* Y1, const LAS unsigned char* X2, const LAS unsigned char* Y2, int wave, int lane, const Epi& epi) {
    const int c = lane & 15, qd = lane >> 4, qt = wave & 3, pt0 = 2 * (wave >> 2);
    const bf16x8 y0 = ldfrag(Y1, 16 * qt + c, 8 * qd), y1 = ldfrag(Y1, 16 * qt + c, 32 + 8 * qd), z0 = ldfrag(Y2, 16 * qt + c, 8 * qd), z1 = ldfrag(Y2, 16 * qt + c, 32 + 8 * qd);
    const bf16x8 xa0 = ldfrag(X1, 16 * pt0 + c, 8 * qd), xa1 = ldfrag(X1, 16 * pt0 + c, 32 + 8 * qd), xb0 = ldfrag(X1, 16 * pt0 + 16 + c, 8 * qd), xb1 = ldfrag(X1, 16 * pt0 + 16 + c, 32 + 8 * qd);
    const bf16x8 ua0 = ldfrag(X2, 16 * pt0 + c, 8 * qd), ua1 = ldfrag(X2, 16 * pt0 + c, 32 + 8 * qd), ub0 = ldfrag(X2, 16 * pt0 + 16 + c, 8 * qd), ub1 = ldfrag(X2, 16 * pt0 + 16 + c, 32 + 8 * qd);
    f32x4 da = {0.f, 0.f, 0.f, 0.f}, db = {0.f, 0.f, 0.f, 0.f};
    da = RK_MFMA(xa0, y0, da); db = RK_MFMA(xb0, y0, db); da = RK_MFMA(xa1, y1, da); db = RK_MFMA(xb1, y1, db);
    da = RK_MFMA(ua0, z0, da); db = RK_MFMA(ub0, z0, db); da = RK_MFMA(ua1, z1, da); db = RK_MFMA(ub1, z1, db);
    epi(pt0, qt, da, 16 * pt0 + 4 * qd, 16 * qt + c); epi(pt0 + 1, qt, db, 16 * pt0 + 16 + 4 * qd, 16 * qt + c);
}
constexpr float EM05 = 0.6065306597126334f;
__device__ __forceinline__ int opq(int v) { asm volatile("" : "+v"(v)); return v; }
#define RK_SLOT(n) (lds + ((n) < 16 ? (n) * rk::TILE : 132096 + ((n) - 16) * rk::TILE))
struct R1Const { const float* kk_p; const float* ka_p; const float* rk_p; const float* cw; int cg; };

struct Raw { unsigned pr[5], pk[5], pv[5], ph[5]; };
__device__ __forceinline__ void r1_unit_geom(int b, int chunk, size_t& rowbase, int& t0, int& seqlen) {
    const bool lat = chunk >= 4; const int lc = chunk - 4;
    rowbase = lat ? (size_t)b * 4096 + (size_t)lc * 64 : (size_t)16384 + (size_t)b * 256 + (size_t)chunk * 64; t0 = lat ? lc * 64 : chunk * 64; seqlen = lat ? 4096 : 256; }
__device__ __forceinline__ void r1_load_raw(Raw& R, const bf16* RW, int b, int h, int chunk, int lane, int wave) {
    size_t rowbase; int t0, seqlen; r1_unit_geom(b, chunk, rowbase, t0, seqlen);
    const int tl0 = 8 * wave, cg = h * 64 + lane;
#pragma unroll
    for (int j = 0; j < 5; ++j) { unsigned a[2], b2[2], c2[2], d2[2];
#pragma unroll
        for (int u = 0; u < 2; ++u) { const int e = 2 * j + u; const int t = t0 + tl0 - 1 + e; const bool ok = t >= 0 && t < seqlen; const bf16* p = RW + (rowbase + (ok ? tl0 - 1 + e : tl0)) * RWP;
            const unsigned a_ = p[cg], b_ = p[512 + cg], c_ = p[1024 + cg], d_ = p[1536 + lane];
            a[u] = ok ? a_ : 0u; b2[u] = ok ? b_ : 0u; c2[u] = ok ? c_ : 0u; d2[u] = ok ? d_ : 0u; }
        R.pr[j] = a[0] | (a[1] << 16); R.pk[j] = b2[0] | (b2[1] << 16); R.pv[j] = c2[0] | (c2[1] << 16); R.ph[j] = d2[0] | (d2[1] << 16); }
}
#define RK_RAW(arr, e) (((e) & 1) ? bf_hi(arr[(e) >> 1]) : bf_lo(arr[(e) >> 1]))

template <int DIR> __device__ __forceinline__ void r1_elem(LAS unsigned char* lds, const R1Const& K, const float (&rv)[8], const float (&kv)[8], const float (&vv)[8], const float (&kk)[8], bool lat, bf16* BVg, int lane_in, int wave) {
    const int lane = opq(lane_in);
    const int g = wave, tl0 = 8 * g;
    const int cgk = opq(K.cg); const float K_kac = K.ka_p[cgk], K_rkc = K.rk_p[cgk];
    LAS unsigned char* sWL = RK_SLOT(DIR == 0 ? 1 : 16); LAS unsigned char* sAL = RK_SLOT(DIR == 0 ? 3 : 17); LAS unsigned char* sAL0 = RK_SLOT(3);
    LAS float* PS = (LAS float*)(RK_SLOT(0) + 5120); LAS float* GC = (LAS float*)(RK_SLOT(0) + 4608);
    float ld[8], av[8];
    float psum = 0.f;
#pragma unroll
    for (int e = 0; e < 8; ++e) {
        const float wl = bf2f(*(const LAS bf16*)(sWL + toff(tl0 + e, lane))), al = bf2f(*(const LAS bf16*)(sAL + toff(tl0 + e, lane)));
        ld[e] = -EM05 * sigmoidf_(wl); av[e] = sigmoidf_(al); psum += ld[e];
        if (DIR == 1 && lat) {
            const float a0 = sigmoidf_(bf2f(*(const LAS bf16*)(sAL0 + toff(tl0 + e, lane))));
            const float bs = wave_sum(rv[e] * kv[e] * (2.0f + (a0 + av[e] - 2.0f) * K_kac) * K_rkc);
            BVg[(tl0 + e) * 64 + lane] = (bf16)f2bf(bs * vv[e]); }
    }
    PS[g * 64 + lane] = psum;
    RK_BAR();
    float carry = 0.f, total = 0.f;
#pragma unroll
    for (int gg = 0; gg < 8; ++gg) { const float s = PS[gg * 64 + lane]; total += s; if (DIR == 0 ? (gg < g) : (gg > g)) carry += s; }
    if (g == 0) GC[lane] = fast_exp(total);
    float lam = carry;
    unsigned atT[4], bhT[4], khT[4], vT[4];
    float h_at = 0.f, h_bh = 0.f, h_kh = 0.f, h_v = 0.f;
#pragma unroll
    for (int s = 0; s < 8; ++s) {
        const int e = DIR == 0 ? s : 7 - s;
        const int ip = DIR == 0 ? tl0 + e : 63 - (tl0 + e);
        lam += ld[e];
        const float G_ = fast_exp(lam), Gp = fast_exp(lam - ld[e]), iG = fast_exp(-lam), GCG = fast_exp(total - lam);
        const float kd = kv[e] * (1.0f + (av[e] - 1.0f) * K_kac), be = kk[e] * av[e];
        const float at = -kk[e] * Gp, rt = rv[e] * G_, bt = be * iG, kt = kd * iG, bh = be * GCG, kh = kd * GCG;
        *(LAS bf16*)(RK_SLOT(4) + toff(ip, lane)) = (bf16)f2bf(at); *(LAS bf16*)(RK_SLOT(6) + toff(ip, lane)) = (bf16)f2bf(rt);
        *(LAS bf16*)(RK_SLOT(7) + toff(ip, lane)) = (bf16)f2bf(bt); *(LAS bf16*)(RK_SLOT(8) + toff(ip, lane)) = (bf16)f2bf(kt);
        if (s & 1) { atT[s >> 1] = pkbf(h_at, at); bhT[s >> 1] = pkbf(h_bh, bh); khT[s >> 1] = pkbf(h_kh, kh); vT[s >> 1] = pkbf(h_v, vv[e]); }
        else { h_at = at; h_bh = bh; h_kh = kh; h_v = vv[e]; }
    }
    const int ip0 = DIR == 0 ? tl0 : 56 - tl0;
    *(LAS v4u*)(RK_SLOT(5) + toff(lane, ip0)) = (v4u){atT[0], atT[1], atT[2], atT[3]};
    *(LAS v4u*)(RK_SLOT(9) + toff(lane, ip0)) = (v4u){bhT[0], bhT[1], bhT[2], bhT[3]};
    *(LAS v4u*)(RK_SLOT(10) + toff(lane, ip0)) = (v4u){khT[0], khT[1], khT[2], khT[3]};
    *(LAS v4u*)(RK_SLOT(11) + toff(lane, ip0)) = (v4u){vT[0], vT[1], vT[2], vT[3]};
}

__device__ __forceinline__ void r1_unit(KP A, LAS unsigned char* lds, const R1Const& K, const Raw& R, int b, int h, int chunk, int tid, int lane, int wave) {
    unsigned char* ws = A->ws;
    const bf16* RW = (const bf16*)(ws + WS_RW);
    const bool lat = chunk >= 4; const int lc = chunk - 4;
    size_t rowbase; int t0, seqlen; r1_unit_geom(b, chunk, rowbase, t0, seqlen);
    bf16* OUT = lat ? (bf16*)(ws + WS_R1L) + ((size_t)(b * 8 + h) * 64 + lc) * (8 * 4096) : (bf16*)(ws + WS_R1C) + ((size_t)(b * 8 + h) * 4 + chunk) * (4 * 4096);
    const int qt = wave & 3, pt0 = 2 * (wave >> 2);
    const float* cw = A->in[I_CONVW];
    const int lane_in = lane;
    bf16x8 wf[4][2];
    { const int ln = opq(lane_in); const bf16* WL = (const bf16*)(ws + WS_WLORA) + (size_t)h * (4 * 64 * 32) + (16 * pt0 + (ln & 15)) * 32 + 8 * (ln >> 4);
#pragma unroll
      for (int m = 0; m < 4; ++m)
#pragma unroll
          for (int i = 0; i < 2; ++i) wf[m][i] = *(const bf16x8*)(WL + m * (64 * 32) + i * (16 * 32)); }
    { const int lane = opq(lane_in); const int tl0 = 8 * wave;
      if (h == 0 && lat) { bf16* HGS = (bf16*)(ws + WS_HGS);
#pragma unroll
          for (int part = 0; part < 2; ++part) { const int ch = part * 64 + lane; if (ch < 96) { const int cl = 1600 + ch; const float g0 = cw[cl], g1 = cw[RWW + cl], g2 = cw[2 * RWW + cl];
              float y[10];
#pragma unroll
              for (int e = 0; e < 10; ++e) { const int t = t0 + tl0 - 1 + e; const bool ok = t >= 0 && t < seqlen; const float a_ = bf2f(RW[(rowbase + (ok ? tl0 - 1 + e : tl0)) * RWP + cl]); y[e] = ok ? a_ : 0.f; }
#pragma unroll
              for (int e = 0; e < 8; ++e) HGS[(rowbase + tl0 + e) * 96 + ch] = (bf16)f2bf(sigmoidf_(g0 * y[e] + g1 * y[e + 1] + g2 * y[e + 2])); } } }
    }
    float rv[8], kv[8], vv[8], kk[8];
    { const int lane = opq(lane_in); const int tl0 = 8 * wave, col = 1536 + lane; const float c0 = cw[col], c1 = cw[RWW + col], c2 = cw[2 * RWW + col];
      const int cga = opq(K.cg); const float K_kkc = K.kk_p[cga];
      const float K_cr0 = cw[cga], K_cr1 = cw[RWW + cga], K_cr2 = cw[2 * RWW + cga], K_ck0 = cw[512 + cga], K_ck1 = cw[RWW + 512 + cga], K_ck2 = cw[2 * RWW + 512 + cga], K_cv0 = cw[1024 + cga], K_cv1 = cw[RWW + 1024 + cga], K_cv2 = cw[2 * RWW + 1024 + cga];
#pragma unroll
      for (int e = 0; e < 8; ++e) {
          rv[e] = K_cr0 * RK_RAW(R.pr, e) + K_cr1 * RK_RAW(R.pr, e + 1) + K_cr2 * RK_RAW(R.pr, e + 2); kv[e] = K_ck0 * RK_RAW(R.pk, e) + K_ck1 * RK_RAW(R.pk, e + 1) + K_ck2 * RK_RAW(R.pk, e + 2); vv[e] = K_cv0 * RK_RAW(R.pv, e) + K_cv1 * RK_RAW(R.pv, e + 1) + K_cv2 * RK_RAW(R.pv, e + 2);
          const float kkr = kv[e] * K_kkc; const float ss = wave_sum(kkr * kkr); kk[e] = kkr * __builtin_amdgcn_rsqf(fmaxf(ss, 1e-24f));
          const float v = c0 * RK_RAW(R.ph, e) + c1 * RK_RAW(R.ph, e + 1) + c2 * RK_RAW(R.ph, e + 2);
          const float o = lane < 32 ? 1.0f - 2.0f * fast_rcp(1.0f + fast_exp(2.0f * v)) : v;
          *(LAS bf16*)(RK_SLOT(0) + toff(tl0 + e, lane)) = (bf16)f2bf(o); }
    }
    RK_BAR();
    { const int lane = opq(lane_in); const int c = lane & 15, qd = lane >> 4;
      const bf16x8 yth = ldfrag(RK_SLOT(0), 16 * qt + c, 8 * qd), yha = ldfrag(RK_SLOT(0), 16 * qt + c, 32 + 8 * qd);
#pragma unroll
      for (int dd = 0; dd < 2; ++dd)
#pragma unroll
          for (int i = 0; i < 2; ++i) { const int p0 = 16 * (pt0 + i) + 4 * qd, q = 16 * qt + c;
              const f32x4 bw = *(const f32x4*)(A->in[I_DW0] + dd * 512 + h * 64 + p0), ba = *(const f32x4*)(A->in[I_IA0] + dd * 512 + h * 64 + p0);
              const f32x4 dw = RK_MFMA(wf[dd][i], yth, bw), da = RK_MFMA(wf[2 + dd][i], yha, ba);
              st_nat(RK_SLOT(dd == 0 ? 1 : 16), q, p0, dw); st_nat(RK_SLOT(dd == 0 ? 3 : 17), q, p0, da); } }
    RK_BAR();
#pragma unroll 1
    for (int d = 0; d < 2; ++d) {
        bf16* BVg = OUT + 7 * 4096;
        if (d == 0) r1_elem<0>(lds, K, rv, kv, vv, kk, lat, BVg, lane_in, wave); else r1_elem<1>(lds, K, rv, kv, vv, kk, lat, BVg, lane_in, wave);
        RK_BAR();
        const int lane = opq(lane_in); const int c = lane & 15, qd = lane >> 4;
        { LAS float* LD = (LAS float*)RK_SLOT(0);
          mm64(RK_SLOT(4), RK_SLOT(7), wave, lane, [&](int pt, int qtt, f32x4 dd, int p0, int q) {
              if (pt == qtt) {
#pragma unroll
                  for (int r = 0; r < 4; ++r) LD[(pt * 16 + 4 * qd + r) * 17 + c] = (q < p0 + r) ? dd[r] : 0.f;
                  st_nat(RK_SLOT(12), q, p0, (f32x4){0.f, 0.f, 0.f, 0.f});
              } else st_nat(RK_SLOT(12), q, p0, pt > qtt ? dd : (f32x4){0.f, 0.f, 0.f, 0.f}); });
          mm64(RK_SLOT(8), RK_SLOT(4), wave, lane, [&](int, int, f32x4 dd, int p0, int q) {
#pragma unroll
              for (int r = 0; r < 4; ++r) dd[r] = (p0 + r < q) ? dd[r] : 0.f;
              st_nat(RK_SLOT(13), q, p0, dd); });
          mm64(RK_SLOT(7), RK_SLOT(6), wave, lane, [&](int, int, f32x4 dd, int p0, int q) {
#pragma unroll
              for (int r = 0; r < 4; ++r) dd[r] = (p0 + r <= q) ? dd[r] : 0.f;
              st_nat(RK_SLOT(14), q, p0, dd); });
          mm64(RK_SLOT(8), RK_SLOT(6), wave, lane, [&](int, int, f32x4 dd, int p0, int q) {
#pragma unroll
              for (int r = 0; r < 4; ++r) dd[r] = (p0 + r <= q) ? dd[r] : 0.f;
              st_nat(RK_SLOT(15), q, p0, dd); }); }
        RK_BAR();
        mm64(RK_SLOT(13), RK_SLOT(11), wave, lane, [&](int, int, f32x4 dd, int p0, int q) { st_nat(RK_SLOT(4), q, p0, dd); });
        { const int zr = tid >> 3, zc = (tid & 7) ^ (zr & 7);
          if ((zc >> 1) != (zr >> 4)) { ((LAS v4u*)RK_SLOT(7))[tid] = (v4u){0u, 0u, 0u, 0u}; ((LAS v4u*)RK_SLOT(8))[tid] = (v4u){0u, 0u, 0u, 0u}; } }
        if (wave == 0) { const LAS float* LD = (const LAS float*)RK_SLOT(0); const int blk = lane >> 4, col = lane & 15;
            float pacc[16];
#pragma unroll
            for (int t = 0; t < 16; ++t) pacc[t] = (t == col) ? 1.0f : 0.0f;
#pragma unroll
            for (int r = 0; r < 15; ++r) {
#pragma unroll
                for (int t = r + 1; t < 16; ++t) pacc[t] += LD[(blk * 16 + t) * 17 + r] * pacc[r]; }
#pragma unroll
            for (int r = 0; r < 16; ++r) *(LAS bf16*)(RK_SLOT(7) + toff(blk * 16 + r, blk * 16 + col)) = (bf16)f2bf(pacc[r]);
            *(LAS v4u*)(RK_SLOT(8) + toff(blk * 16 + col, blk * 16)) = (v4u){pkbf(pacc[0], pacc[1]), pkbf(pacc[2], pacc[3]), pkbf(pacc[4], pacc[5]), pkbf(pacc[6], pacc[7])};
            *(LAS v4u*)(RK_SLOT(8) + toff(blk * 16 + col, blk * 16 + 8)) = (v4u){pkbf(pacc[8], pacc[9]), pkbf(pacc[10], pacc[11]), pkbf(pacc[12], pacc[13]), pkbf(pacc[14], pacc[15])}; }
        RK_BAR();
        mm64(RK_SLOT(7), RK_SLOT(12), wave, lane, [&](int, int, f32x4 dd, int p0, int q) { st_tr(RK_SLOT(1), p0, q, dd); st_nat(RK_SLOT(2), q, p0, dd); });
        RK_BAR();
        mm64(RK_SLOT(1), RK_SLOT(2), wave, lane, [&](int, int, f32x4 dd, int p0, int q) {
#pragma unroll
            for (int r = 0; r < 4; ++r) dd[r] += (p0 + r == q) ? 1.0f : 0.0f;
            st_nat(RK_SLOT(12), q, p0, dd); });
        RK_BAR();
        mm64(RK_SLOT(1), RK_SLOT(12), wave, lane, [&](int, int, f32x4 dd, int p0, int q) {
            const v2u w = *(const LAS v2u*)(RK_SLOT(12) + toff(q, p0));
            dd[0] += bf_lo(w.x); dd[1] += bf_hi(w.x); dd[2] += bf_lo(w.y); dd[3] += bf_hi(w.y);
            st_tr(RK_SLOT(13), p0, q, dd); });
        RK_BAR();
        mm64(RK_SLOT(13), RK_SLOT(8), wave, lane, [&](int, int, f32x4 dd, int p0, int q) { st_tr(RK_SLOT(2), p0, q, dd); });
        RK_BAR();
        mm64(RK_SLOT(2), RK_SLOT(5), wave, lane, [&](int, int, f32x4 dd, int p0, int q) { st_nat(RK_SLOT(7), q, p0, dd); });
        mm64(RK_SLOT(2), RK_SLOT(4), wave, lane, [&](int, int, f32x4 dd, int p0, int q) { st_nat(RK_SLOT(1), q, p0, dd); });
        RK_BAR();
        { bf16* Gg = OUT + (2 * d) * 4096; bf16* HTg = OUT + (2 * d + 1) * 4096;
          const LAS float* GC = (const LAS float*)(RK_SLOT(0) + 4608);
          mm64(RK_SLOT(7), RK_SLOT(9), wave, lane, [&](int, int, f32x4 dd, int p0, int q) {
#pragma unroll
              for (int r = 0; r < 4; ++r) dd[r] += (p0 + r == q) ? GC[q] : 0.0f;
              st_gnat(Gg, q, p0, dd); });
          mm64_2(RK_SLOT(9), RK_SLOT(1), RK_SLOT(10), RK_SLOT(11), wave, lane, [&](int, int, f32x4 dd, int p0, int q) { st_gnat(HTg, q, p0, dd); });
          if (lat) { bf16* YSg = OUT + (4 + d) * 4096; bf16* Y0g = OUT + 6 * 4096;
              mm64(RK_SLOT(7), RK_SLOT(14), wave, lane, [&](int, int, f32x4 dd, int p0, int q) {
                  const v2u w = *(const LAS v2u*)(RK_SLOT(6) + toff(q, p0));
                  dd[0] += bf_lo(w.x); dd[1] += bf_hi(w.x); dd[2] += bf_lo(w.y); dd[3] += bf_hi(w.y);
                  st_gnat(YSg, q, p0, dd); });
              mm64_2(RK_SLOT(1), RK_SLOT(14), RK_SLOT(11), RK_SLOT(15), wave, lane, [&](int, int, f32x4 dd, int p0, int q) {
                  if (d == 0) st_nat(RK_SLOT(18), q, p0, dd);
                  else { const v2u w = *(const LAS v2u*)(RK_SLOT(18) + toff(63 - q, p0));
                      dd[0] += bf_lo(w.x); dd[1] += bf_hi(w.x); dd[2] += bf_lo(w.y); dd[3] += bf_hi(w.y);
                      st_gnat(Y0g, 63 - q, p0, dd); } }); } }
        RK_BAR();
    }
}

__device__ __forceinline__ void phase_r1(KP A, LAS unsigned char* lds, int vcu, int G, int tid, int lane, int wave) {
    const int h = (vcu >> 5) & 7;
    R1Const K; K.kk_p = A->in[I_KK]; K.ka_p = A->in[I_KA]; K.rk_p = A->in[I_RK]; K.cw = A->in[I_CONVW]; K.cg = h * 64 + lane;
    if (G != 256) return;
    const bf16* RW = (const bf16*)(A->ws + WS_RW);
    Raw cur, nxt;
    { const int idx = vcu & 31; r1_load_raw(nxt, RW, idx / 68, h, idx % 68, lane, wave); }
#pragma unroll 1
    for (int i = 0; i < 9; ++i) { const int idx = i * 32 + (vcu & 31); if (idx >= 272) break;
        cur = nxt;
        { const int idn = idx + 32; if (idn < 272) r1_load_raw(nxt, RW, idn / 68, h, idn % 68, lane, wave); }
        r1_unit(A, lds, K, cur, idx / 68, h, idx % 68, tid, lane, wave); }
}

__device__ __forceinline__ void phase_r2(KP A, LAS unsigned char* lds, int vcu, int G, int tid, int lane, int wave) {
    unsigned char* ws = A->ws;
    constexpr int SLOT = 8192 + 2304, BATCH = 4;
    for (int unit = vcu; unit < 256; unit += G) {
        const int b = unit >> 6, h = (unit >> 3) & 7, dir = (unit >> 2) & 1, vq = unit & 3;
        const int c = lane & 15, qd = lane >> 4;
        LAS unsigned char* ZT = lds + 2 * BATCH * SLOT;
        bf16x8 zy0 = (bf16x8){0, 0, 0, 0, 0, 0, 0, 0}, zy1 = zy0;
#define R2_SRC(step, Gp, Hp, cid) do { cid = dir == 0 ? (step) : ((step) < 4 ? 3 - (step) : 71 - (step)); \
            const bf16* base_ = cid < 4 ? (const bf16*)(ws + WS_R1C) + ((size_t)(b * 8 + h) * 4 + cid) * (4 * 4096) : (const bf16*)(ws + WS_R1L) + ((size_t)(b * 8 + h) * 64 + (cid - 4)) * (8 * 4096); \
            Gp = base_ + (2 * dir) * 4096; Hp = base_ + (2 * dir + 1) * 4096; } while (0)
#define R2_STAGE(nb) do { const int step_ = (nb) * BATCH + (wave - 1); if (step_ < 68) { const bf16* Gp; const bf16* Hp; int cid_; R2_SRC(step_, Gp, Hp, cid_); (void)cid_; \
            LAS unsigned char* dst = lds + (((nb) & 1) * BATCH + (wave - 1)) * SLOT; \
            _Pragma("unroll") for (int i = 0; i < 8; ++i) { const int idx = i * 64 + lane, row = idx >> 3, ch = idx & 7; const v4u v = *(const v4u*)(Gp + row * 64 + ch * 8); *(LAS v4u*)(dst + rk::toff(row, ch * 8)) = v; } \
            _Pragma("unroll") for (int i = 0; i < 2; ++i) { const int idx = i * 64 + lane, row = idx >> 3, ch = idx & 7; const v4u v = *(const v4u*)(Hp + (16 * vq + row) * 64 + ch * 8); *(LAS v4u*)(dst + 8192 + row * 144 + ch * 16) = v; } } } while (0)
        if (wave >= 1 && wave <= BATCH) R2_STAGE(0);
        __syncthreads();
        for (int nb = 0; nb < 17; ++nb) {
            if (wave >= 1 && wave <= BATCH) { if (nb + 1 < 17) R2_STAGE(nb + 1); }
            else if (wave == 0) {
                for (int s = 0; s < BATCH; ++s) { const int step = nb * BATCH + s; if (step >= 68) break;
                    const bf16* Gp; const bf16* Hp; int cid; R2_SRC(step, Gp, Hp, cid); (void)Gp; (void)Hp;
                    const LAS unsigned char* src = lds + ((nb & 1) * BATCH + s) * SLOT;
                    if (cid >= 4) { bf16* Z0 = (bf16*)(ws + WS_Z0) + ((size_t)((b * 8 + h) * 2 + dir) * 64 + (cid - 4)) * 4096 + (16 * vq + c) * 64 + 8 * qd;
                        *(bf16x8*)Z0 = zy0; *(bf16x8*)(Z0 + 32) = zy1; }
                    f32x4 acc[4];
#pragma unroll
                    for (int pt = 0; pt < 4; ++pt) { const v2u hv = *(const LAS v2u*)(src + 8192 + c * 144 + (16 * pt + 4 * qd) * 2);
                        acc[pt] = (f32x4){bf_lo(hv.x), bf_hi(hv.x), bf_lo(hv.y), bf_hi(hv.y)};
                        acc[pt] = RK_MFMA(rk::ldfrag(src, 16 * pt + c, 8 * qd), zy0, acc[pt]);
                        acc[pt] = RK_MFMA(rk::ldfrag(src, 16 * pt + c, 32 + 8 * qd), zy1, acc[pt]); }
#pragma unroll
                    for (int pt = 0; pt < 4; ++pt) { v2u w; w.x = rk::pkbf(acc[pt][0], acc[pt][1]); w.y = rk::pkbf(acc[pt][2], acc[pt][3]); *(LAS v2u*)(ZT + c * 144 + (16 * pt + 4 * qd) * 2) = w; }
                    zy0 = *(const LAS bf16x8*)(ZT + c * 144 + (8 * qd) * 2); zy1 = *(const LAS bf16x8*)(ZT + c * 144 + (32 + 8 * qd) * 2);
                }
            }
            __syncthreads();
        }
#undef R2_STAGE
#undef R2_SRC
    }
}

__device__ __forceinline__ void phase_r3(KP A, LAS unsigned char* lds, int vcu, int G, int tid, int lane, int wave) {
    unsigned char* ws = A->ws;
    const int h = (vcu >> 5) & 7, c = lane & 15, qd = lane >> 4, tt = wave & 3, vh = wave >> 2;
    bf16x8 gf[2][3];
#pragma unroll
    for (int i = 0; i < 2; ++i)
#pragma unroll
        for (int s = 0; s < 3; ++s) { const float* src = A->in[I_GG2] + h * 64 + 32 * vh + 16 * i + c; float t[8];
#pragma unroll
            for (int j = 0; j < 8; ++j) t[j] = src[(size_t)(32 * s + 8 * qd + j) * 512];
            v4u w = {pkbf(t[0], t[1]), pkbf(t[2], t[3]), pkbf(t[4], t[5]), pkbf(t[6], t[7])}; gf[i][s] = __builtin_bit_cast(bf16x8, w); }
    f32x4 lw[2], lb[2];
#pragma unroll
    for (int i = 0; i < 2; ++i) { lw[i] = *(const f32x4*)(A->in[I_LNXW] + h * 64 + 32 * vh + 16 * i + 4 * qd); lb[i] = *(const f32x4*)(A->in[I_LNXB] + h * 64 + 32 * vh + 16 * i + 4 * qd); }
    LAS float* XS = (LAS float*)lds;
    if (G != 256) return;
    for (int it = 0; it < 8; ++it) { const int idx = it * 32 + (vcu & 31), b = idx >> 6, lc = idx & 63;
        const bf16* T8 = (const bf16*)(ws + WS_R1L) + ((size_t)(b * 8 + h) * 64 + lc) * (8 * 4096);
        const int tok = 16 * tt + c; const size_t row = (size_t)b * 4096 + (size_t)lc * 64 + tok;
        f32x4 acc[2];
#pragma unroll
        for (int i = 0; i < 2; ++i) { const v2u w = *(const v2u*)(T8 + 6 * 4096 + tok * 64 + 32 * vh + 16 * i + 4 * qd); acc[i] = (f32x4){bf_lo(w.x), bf_hi(w.x), bf_lo(w.y), bf_hi(w.y)}; }
#pragma unroll
        for (int d = 0; d < 2; ++d) { const bf16* Z0 = (const bf16*)(ws + WS_Z0) + ((size_t)((b * 8 + h) * 2 + d) * 64 + lc) * 4096;
            const bf16* YS = T8 + (4 + d) * 4096 + (d == 0 ? tok : 63 - tok) * 64;
            const bf16x8 y0 = *(const bf16x8*)(YS + 8 * qd), y1 = *(const bf16x8*)(YS + 32 + 8 * qd);
#pragma unroll
            for (int i = 0; i < 2; ++i) { const bf16* zr = Z0 + (32 * vh + 16 * i + c) * 64;
                acc[i] = RK_MFMA(*(const bf16x8*)(zr + 8 * qd), y0, acc[i]); acc[i] = RK_MFMA(*(const bf16x8*)(zr + 32 + 8 * qd), y1, acc[i]); } }
        float s1 = 0.f, s2 = 0.f;
#pragma unroll
        for (int i = 0; i < 2; ++i)
#pragma unroll
            for (int r = 0; r < 4; ++r) { s1 += acc[i][r]; s2 += acc[i][r] * acc[i][r]; }
        s1 += __shfl_xor(s1, 16); s1 += __shfl_xor(s1, 32); s2 += __shfl_xor(s2, 16); s2 += __shfl_xor(s2, 32);
        if (qd == 0) { XS[(vh * 64 + tok) * 2] = s1; XS[(vh * 64 + tok) * 2 + 1] = s2; }
        __syncthreads();
        const float t1 = XS[tok * 2] + XS[(64 + tok) * 2], t2 = XS[tok * 2 + 1] + XS[(64 + tok) * 2 + 1];
        const float mu = t1 * (1.f / 64.f), var = fmaxf(t2 * (1.f / 64.f) - mu * mu, 0.f), rstd = __builtin_amdgcn_rsqf(var + LNX_EPS);
        const bf16* hg = (const bf16*)(ws + WS_HGS) + row * 96;
        f32x4 gacc[2] = {(f32x4){0.f, 0.f, 0.f, 0.f}, (f32x4){0.f, 0.f, 0.f, 0.f}};
#pragma unroll
        for (int s = 0; s < 3; ++s) { const bf16x8 yh = *(const bf16x8*)(hg + 32 * s + 8 * qd);
#pragma unroll
            for (int i = 0; i < 2; ++i) gacc[i] = RK_MFMA(gf[i][s], yh, gacc[i]); }
        bf16* YRW = (bf16*)(ws + WS_YRW) + row * 512 + h * 64;
#pragma unroll
        for (int i = 0; i < 2; ++i) { const int v0 = 32 * vh + 16 * i + 4 * qd;
            const v2u bw = *(const v2u*)(T8 + 7 * 4096 + tok * 64 + v0);
            const float bv[4] = {bf_lo(bw.x), bf_hi(bw.x), bf_lo(bw.y), bf_hi(bw.y)};
            f32x4 o;
#pragma unroll
            for (int r = 0; r < 4; ++r) o[r] = ((acc[i][r] - mu) * rstd * lw[i][r] + lb[i][r] + bv[r]) * gacc[i][r];
            v2u w; w.x = pkbf(o[0], o[1]); w.y = pkbf(o[2], o[3]); *(v2u*)(YRW + v0) = w; }
        __syncthreads();
    }
}
#undef RK_SLOT
#undef RK_MFMA
}
__device__ __forceinline__ int win_col(int n) {
    if (n < 640) { const int base = n & ~63, p = n & 63; return base + (p >> 1) + 32 * (p & 1); }
    if (n < 768) return n;
    if (n < 2560) { const int j = n - 768; return j < RWW ? 768 + j : -1; }
    return 2464 + (n - 2560);
}
template <bool MAPPED> __device__ __forceinline__ void transpose_item(const float* W, int K, int N, bf16* WT, LAS float* scr, int item, int nblk, int lane) {
    const int kb = item / nblk, nb = item % nblk, k0 = 64 * kb, n0 = 32 * nb;
    const int oc = MAPPED ? win_col(n0 + (lane & 31)) : (n0 + (lane & 31));
#pragma unroll 8
    for (int i = 0; i < 32; ++i) { const int kk = 2 * i + (lane >> 5); scr[kk * 33 + (lane & 31)] = oc >= 0 ? W[(size_t)(k0 + kk) * N + oc] : 0.f; }
    LDS_WAIT(); asm volatile("" ::: "memory");
    const int c = lane & 7;
#pragma unroll
    for (int j = 0; j < 4; ++j) { const int n = (lane >> 3) + 8 * j; const LAS float* s = scr + (8 * c) * 33 + n;
        v4u o; o.x = pk2(s[0 * 33], s[1 * 33]); o.y = pk2(s[2 * 33], s[3 * 33]); o.z = pk2(s[4 * 33], s[5 * 33]); o.w = pk2(s[6 * 33], s[7 * 33]);
        *(GAS v4u*)(WT + (size_t)(n0 + n) * K + k0 + 8 * c) = o; }
    LDS_WAIT(); asm volatile("" ::: "memory");
}

__device__ __forceinline__ void sincos_f(float ang, float& s, float& c) {
    const float k = rintf(ang * 0.63661977236758134f);
    float r = fmaf(-k, 1.5707963705062866f, ang); r = fmaf(-k, -4.371139006309477e-08f, r);
    const float r2 = r * r;
    const float sp = r + r * r2 * (-1.6666667e-1f + r2 * (8.3333333e-3f + r2 * (-1.9841270e-4f + r2 * 2.7557319e-6f)));
    const float cp = 1.0f + r2 * (-0.5f + r2 * (4.1666667e-2f + r2 * (-1.3888889e-3f + r2 * (2.4801587e-5f + r2 * -2.7557319e-7f))));
    const int q = ((int)k) & 3;
    s = (q == 0) ? sp : (q == 1) ? cp : (q == 2) ? -sp : -cp;
    c = (q == 0) ? cp : (q == 1) ? -sp : (q == 2) ? -cp : sp;
}

__device__ __forceinline__ void phase0(KP A, LAS unsigned char* lds, int vcu, int G, int tid, int lane, int wave) {
    unsigned char* ws = A->ws;
    { LAS float* scr = (LAS float*)(lds + wave * 16384);
      const int gw = vcu * 8 + wave, NGW = G * 8;
      constexpr int I_IN = 16 * (NIN / 32), I_A = 8 * 32, I_O = 16 * 32, I_U = 16 * 128, I_D = 64 * 32;
      constexpr int NITEMS = I_IN + 2 * I_A + I_O + I_U + I_D;
      for (int it = gw; it < NITEMS; it += NGW) {
          int r = it;
          if (r < I_IN) { transpose_item<true>(A->in[I_WIN], 1024, 4512, (bf16*)(ws + WS_WIN), scr, r, NIN / 32, lane); continue; } r -= I_IN;
          if (r < I_A) { transpose_item<false>(A->in[I_WBA], 512, 1024, (bf16*)(ws + WS_WA), scr, r, 32, lane); continue; } r -= I_A;
          if (r < I_A) { transpose_item<false>(A->in[I_WBR], 512, 1024, (bf16*)(ws + WS_WR), scr, r, 32, lane); continue; } r -= I_A;
          if (r < I_O) { transpose_item<false>(A->in[I_WOUT], 1024, 1024, (bf16*)(ws + WS_WO), scr, r, 32, lane); continue; } r -= I_O;
          if (r < I_U) { transpose_item<false>(A->in[I_WUP], 1024, 4096, (bf16*)(ws + WS_WU), scr, r, 128, lane); continue; } r -= I_U;
          transpose_item<false>(A->in[I_WDN], 4096, 1024, (bf16*)(ws + WS_WD), scr, r, 32, lane);
      } }
    { float* COS = (float*)(ws + WS_ROPE); float* SIN = COS + 4096 * 32;
      const float invf[16] = {1.0f, 0.5623413324356079f, 0.3162277638912201f, 0.17782793939113617f, 0.10000000149011612f, 0.05623413249850273f, 0.03162277489900589f, 0.017782794311642647f,
                              0.009999999776482582f, 0.005623413249850273f, 0.003162277629598975f, 0.0017782794311642647f, 0.0010000000474974513f, 0.000562341301701963f, 0.0003162277571391314f, 0.00017782794020604342f};
      for (int e = vcu * 512 + tid; e < 4096 * 32; e += G * 512) {
          const int pos = e >> 5, i = e & 31; float f = invf[0];
#pragma unroll
          for (int q = 1; q < 16; ++q) f = ((i & 15) == q) ? invf[q] : f;
          const float ang = (float)(i < 16 ? (pos >> 6) : (pos & 63)) * f;
          float s, c; sincos_f(ang, s, c); COS[e] = c; SIN[e] = s; } }
    { bf16* WL = (bf16*)(ws + WS_WLORA);
      for (int e = vcu * 512 + tid; e < 65536; e += G * 512) { const int hh = e >> 13, m = (e >> 11) & 3, ch = (e >> 5) & 63, j = e & 31;
          WL[e] = (bf16)f2bf((m < 2 ? A->in[I_DW2] : A->in[I_IA2])[(size_t)((m & 1) * 32 + j) * 512 + hh * 64 + ch]); } }
    __syncthreads();
    { LAS float* SC = (LAS float*)lds;
      LAS float* RED = (LAS float*)(lds + 32768);
      for (int e = tid; e < 5 * 1024; e += 512) { const int b = e >> 10, k = e & 1023; const float v = b < 4 ? A->in[I_C][b * 1024 + k] : A->in[I_CCTX][k]; SC[e] = v * sigmoidf_(v); }
      __syncthreads();
      float* MOD = (float*)(ws + WS_MOD);
      for (int slab = vcu; slab < 192; slab += G) {
          const int col = tid & 31, kg = tid >> 5, j0 = slab * 32;
          float a0 = 0.f, a1 = 0.f, a2 = 0.f, a3 = 0.f, a4 = 0.f;
          const float* wp = A->in[I_WADA] + (size_t)(kg * 64) * 6144 + j0 + col;
#pragma unroll 8
          for (int k = 0; k < 64; ++k) { const float w = wp[(size_t)k * 6144]; const int kk = kg * 64 + k;
              a0 += SC[kk] * w; a1 += SC[1024 + kk] * w; a2 += SC[2048 + kk] * w; a3 += SC[3072 + kk] * w; a4 += SC[4096 + kk] * w; }
          RED[(kg * 5 + 0) * 32 + col] = a0; RED[(kg * 5 + 1) * 32 + col] = a1; RED[(kg * 5 + 2) * 32 + col] = a2; RED[(kg * 5 + 3) * 32 + col] = a3; RED[(kg * 5 + 4) * 32 + col] = a4;
          __syncthreads();
          if (tid < 160) { const int b = tid >> 5, c = tid & 31; float s = A->in[I_BADA][j0 + c];
#pragma unroll
              for (int g = 0; g < 16; ++g) s += RED[(g * 5 + b) * 32 + c];
              MOD[b * 6144 + j0 + c] = s; }
          __syncthreads();
      } }
}

__device__ __forceinline__ void phase1(KP A, int vcu, int G, int lane, int wave) {
    unsigned char* ws = A->ws; const float* MOD = (const float*)(ws + WS_MOD);
    const int gw = vcu * 8 + wave, NGW = G * 8;
    bf16* HB = (bf16*)(ws + WS_HB);
    for (int m = gw; m < MT; m += NGW) {
        const float* xrow = m < ML ? A->in[I_X] + (size_t)m * DM : A->in[I_CTX] + (size_t)(m - ML) * DM;
        const float* mod = MOD + (m < ML ? (m >> 12) : 4) * 6144;
        const GAS f32x4* xr = (const GAS f32x4*)xrow + lane;
        f32x4 v[4]; float s = 0.f;
#pragma unroll
        for (int j = 0; j < 4; ++j) { v[j] = xr[64 * j]; s += (v[j].x * v[j].x + v[j].y * v[j].y) + (v[j].z * v[j].z + v[j].w * v[j].w); }
        const float rstd = __builtin_amdgcn_rsqf(wave_sum(s) * (1.f / DM) + NORM_EPS);
        GAS unsigned long long* o8 = (GAS unsigned long long*)(HB + (size_t)m * DM) + lane;
#pragma unroll
        for (int j = 0; j < 4; ++j) { const int c = 4 * lane + 256 * j;
            const f32x4 g = *(const f32x4*)(A->in[I_N1G] + c), sh = *(const f32x4*)(mod + c), sc = *(const f32x4*)(mod + 1024 + c);
            const f32x4 h = v[j] * rstd * g * (sc + 1.0f) + sh;
            o8[64 * j] = (unsigned long long)pk2(h.x, h.y) | ((unsigned long long)pk2(h.z, h.w) << 32); }
    }
    const bf16* WU = (const bf16*)(ws + WS_WU); float* CB = (float*)(ws + WS_CB);
    for (int n = gw; n < FF; n += NGW) {
        const v4u* wr = (const v4u*)(WU + (size_t)n * 1024) + 2 * lane;
        const v4u w0 = wr[0], w1 = wr[1];
        float wv[16] = {bf_lo(w0.x), bf_hi(w0.x), bf_lo(w0.y), bf_hi(w0.y), bf_lo(w0.z), bf_hi(w0.z), bf_lo(w0.w), bf_hi(w0.w),
                        bf_lo(w1.x), bf_hi(w1.x), bf_lo(w1.y), bf_hi(w1.y), bf_lo(w1.z), bf_hi(w1.z), bf_lo(w1.w), bf_hi(w1.w)};
#pragma unroll
        for (int b = 0; b < 4; ++b) { const float* sh = MOD + b * 6144 + 3 * 1024 + 16 * lane; float s = 0.f;
#pragma unroll
            for (int e = 0; e < 16; ++e) s += sh[e] * wv[e];
            s = wave_sum(s); if (lane == 0) CB[b * 4096 + n] = s; }
    }
}

__device__ __forceinline__ void phase_final(KP A, int vcu, int G, int lane, int wave) {
    const float* SS = (const float*)(A->ws + WS_SS2);
    const int gw = vcu * 8 + wave, NGW = G * 8;
    for (int m = gw; m < ML; m += NGW) {
        float s = 0.f;
#pragma unroll
        for (int p = 0; p < 16; ++p) s += SS[(size_t)p * 16384 + m];
        const float rstd = __builtin_amdgcn_rsqf(s * (1.f / DM) + NORM_EPS);
        GAS f32x4* xr = (GAS f32x4*)(A->out + (size_t)m * DM) + lane;
#pragma unroll
        for (int j = 0; j < 4; ++j) { const f32x4 g = *(const f32x4*)(A->in[I_NFG] + 4 * lane + 256 * j); xr[64 * j] = xr[64 * j] * rstd * g; }
    }
}

__global__ void __launch_bounds__(512, 2) fwd_kernel(Args args) {
    extern __shared__ __attribute__((aligned(16))) unsigned char lds_raw[];
    LAS unsigned char* lds = (LAS unsigned char*)lds_raw;
    volatile LAS unsigned* MISC = (volatile LAS unsigned*)(lds + MISC_OFF);
    const int tid = threadIdx.x, lane = tid & 63, wave = __builtin_amdgcn_readfirstlane(tid >> 6);
    const int G = gridDim.x; const int bx = blockIdx.x; const int vcu = (G % 8 == 0) ? (bx % 8) * (G / 8) + bx / 8 : bx;
    KP ap = kargs_opaque(); unsigned char* ws = ap->ws;
    gu32* ctl = (gu32*)(ws + WS_CTL);
    for (int u = tid; u < (LDS_BYTES - LDSCTL_OFF) / 4; u += 512) ((LAS unsigned*)(lds + LDSCTL_OFF))[u] = 0u;
    __syncthreads();
    XcdBarrier bar; bar.bar = (unsigned*)(ctl + CW_BAR); bar.x = 0; bar.st = nullptr;
    if (N_LAUNCHES == 1) bar = xcd_barrier_post((unsigned*)(ctl + CW_BAR), MISC + 8);
    const int lo = ap->ph_lo, hi = ap->ph_hi;

#ifndef PHMASK
#define PHMASK 0xFFFu
#endif
#define IN(k) ((((PHMASK) >> (k)) & 1u) && lo <= (k) && (k) < hi)
#define SEAM(k) do { if (IN(k) && IN((k) + 1)) xcd_barrier(bar); } while (0)


#ifndef PROBE_DOUBLE
#define PROBE_DOUBLE 0u
#endif
#define NREP(k) ((((PROBE_DOUBLE) >> (k)) & 1u) ? opaque_i(2) : 1)
    if (IN(0)) { for (int rep_ = 0; rep_ < NREP(0); ++rep_) { ap = kargs_opaque(); ws = ap->ws; phase0(ap, lds, vcu, G, tid, lane, wave); __syncthreads(); } SEAM(0); }
    if (IN(1)) { for (int rep_ = 0; rep_ < NREP(1); ++rep_) { ap = kargs_opaque(); ws = ap->ws; phase1(ap, vcu, G, lane, wave); } SEAM(1); }
    if (IN(2)) { for (int rep_ = 0; rep_ < NREP(2); ++rep_) { ap = kargs_opaque(); ws = ap->ws;
        pg8::Gemm g{(const pg8::bf16_t*)(ws + WS_HB), (const pg8::bf16_t*)(ws + WS_WIN), MT, NIN, DM};
        pg8::OrderX S; S.init(ML, NIN, G, bx, 32, 64, 4, 2);
        pg8::EpiInProj E{(bf16*)(ws + WS_Q), (bf16*)(ws + WS_K), (bf16*)(ws + WS_V), (bf16*)(ws + WS_RW), (bf16*)ap->out, (const float*)(ws + WS_ROPE), (const float*)(ws + WS_ROPE) + 4096 * 32, QSCALE};
        pg8::gemm_phase<pg8::EpiInProj, pg8::OrderX, true, true>(lds, g, S, E);
        }
        SEAM(2);
    }
    if (IN(3)) { for (int rep_ = 0; rep_ < NREP(3); ++rep_) { ap = kargs_opaque(); ws = ap->ws;
        for (int u = vcu; u < 512; u += G) { const int b = u >> 7, g = (u >> 6) & 1, qb = u & 63;
            att::attn_unit(b, g, qb, (const bf16*)(ws + WS_Q), (const bf16*)(ws + WS_K), (const bf16*)(ws + WS_V), (bf16*)(ws + WS_YA), ap->in[I_SINK], lds); }
        }
        SEAM(3);
    }
    if (IN(4)) { ap = kargs_opaque(); ws = ap->ws;
        { pg8::Gemm g{(const pg8::bf16_t*)(ws + WS_YA), (const pg8::bf16_t*)(ws + WS_WA), ML, DM, 512};
          pg8::OrderX S; S.init(ML, DM, G, bx);
          pg8::EpiBranch<0> E{(bf16*)ap->out, nullptr};
          pg8::gemm_phase<pg8::EpiBranch<0>, pg8::OrderX, true, true>(lds, g, S, E); }
        __syncthreads();
        for (int rep_ = 0; rep_ < NREP(4); ++rep_) { ap = kargs_opaque(); rk::phase_r1(ap, lds, vcu, G, tid, lane, wave); }
        SEAM(4);
    }
    if (IN(5)) { for (int rep_ = 0; rep_ < NREP(5); ++rep_) { ap = kargs_opaque(); ws = ap->ws; rk::phase_r2(ap, lds, vcu, G, tid, lane, wave); } SEAM(5); }
    if (IN(6)) { for (int rep_ = 0; rep_ < NREP(6); ++rep_) { ap = kargs_opaque(); ws = ap->ws; rk::phase_r3(ap, lds, vcu, G, tid, lane, wave); } SEAM(6); }
    if (IN(7)) { for (int rep_ = 0; rep_ < NREP(7); ++rep_) { ap = kargs_opaque(); ws = ap->ws;
        pg8::Gemm g{(const pg8::bf16_t*)(ws + WS_YRW), (const pg8::bf16_t*)(ws + WS_WR), ML, DM, 512};
        pg8::OrderX S; S.init(ML, DM, G, bx);
        pg8::EpiBranch<1> E{(bf16*)ap->out, (bf16*)(ws + WS_M1)};
        pg8::gemm_phase<pg8::EpiBranch<1>, pg8::OrderX, true, true>(lds, g, S, E);
        }
        SEAM(7);
    }
    if (IN(8)) { for (int rep_ = 0; rep_ < NREP(8); ++rep_) { ap = kargs_opaque(); ws = ap->ws;
        pg8::Gemm g{(const pg8::bf16_t*)(ws + WS_M1), (const pg8::bf16_t*)(ws + WS_WO), ML, DM, DM};
        pg8::OrderX S; S.init(ML, DM, G, bx);
        pg8::EpiResid<0> E{ap->in[I_X], ap->out, (bf16*)(ws + WS_A2), (const float*)(ws + WS_MOD), ap->in[I_N2G], (float*)(ws + WS_SS1), 2 * 1024};
        pg8::gemm_phase<pg8::EpiResid<0>, pg8::OrderX, true, true>(lds, g, S, E);
        }
        SEAM(8);
    }
    if (IN(9)) { for (int rep_ = 0; rep_ < NREP(9); ++rep_) { ap = kargs_opaque(); ws = ap->ws;
        pg8::Gemm g{(const pg8::bf16_t*)(ws + WS_A2), (const pg8::bf16_t*)(ws + WS_WU), ML, FF, DM};
        pg8::OrderX S; S.init(ML, FF, G, bx);
        pg8::EpiUp E{(bf16*)(ws + WS_U), (const float*)(ws + WS_SS1), (const float*)(ws + WS_CB)};
        pg8::gemm_phase<pg8::EpiUp, pg8::OrderX, true, true>(lds, g, S, E);
        }
        SEAM(9);
    }
    if (IN(10)) { ap = kargs_opaque(); ws = ap->ws;
        pg8::Gemm g{(const pg8::bf16_t*)(ws + WS_U), (const pg8::bf16_t*)(ws + WS_WD), ML, DM, FF};
        pg8::OrderX S; S.init(ML, DM, G, bx);
        pg8::EpiResid<1> E{ap->out, ap->out, nullptr, (const float*)(ws + WS_MOD), nullptr, (float*)(ws + WS_SS2), 5 * 1024};
        pg8::gemm_phase<pg8::EpiResid<1>, pg8::OrderX, true, true>(lds, g, S, E);
        SEAM(10);
    }
    if (IN(11)) { ap = kargs_opaque(); ws = ap->ws; phase_final(ap, vcu, G, lane, wave); }
#undef IN
#undef SEAM
}

extern "C" void kernel_launch(void* const* d_in, const int* in_sizes, int n_in, void* d_out, int out_size, void* d_ws, size_t ws_size, hipStream_t stream) {
    static int grid = 0;
    if (grid == 0) {
        if (n_in != 27 || in_sizes[0] != ML * DM || out_size != ML * DM || ws_size < WS_END) {
            fprintf(stderr, "kernel_launch: unexpected shapes (n_in %d, in0 %d, out %d, ws %zu); nothing launched\n", n_in, n_in > 0 ? in_sizes[0] : -1, out_size, ws_size); grid = -1; return; }
        int dev = 0, cus = 0, per_cu = 0;
        if (hipGetDevice(&dev) != hipSuccess || hipDeviceGetAttribute(&cus, hipDeviceAttributeMultiprocessorCount, dev) != hipSuccess) { grid = -1; return; }
        if (hipFuncSetAttribute((const void*)fwd_kernel, hipFuncAttributeMaxDynamicSharedMemorySize, LDS_BYTES) != hipSuccess) { fprintf(stderr, "kernel_launch: hipFuncSetAttribute failed\n"); grid = -1; return; }
        if (hipOccupancyMaxActiveBlocksPerMultiprocessor(&per_cu, (const void*)fwd_kernel, 512, LDS_BYTES) != hipSuccess || per_cu < 1)
            fprintf(stderr, "kernel_launch: note: occupancy query reports %d workgroups per CU\n", per_cu);
        (void)hipGetLastError();
        grid = cus;
    }
    if (grid < 0) return;
    if (hipMemsetAsync((char*)d_ws + WS_CTL, 0, CTL_ZERO_BYTES, stream) != hipSuccess) return;
#ifdef PROBE_ZERO
    (void)hipMemsetAsync((char*)d_ws + CTL_ZERO_BYTES, 0, WS_END - CTL_ZERO_BYTES, stream); (void)hipMemsetAsync(d_out, 0, (size_t)ML * DM * 4, stream);
#endif
    Args a{};
    for (int i = 0; i < 27; ++i) a.in[i] = (const float*)d_in[i];
    a.out = (float*)d_out; a.ws = (unsigned char*)d_ws;
    if (N_LAUNCHES == 1) { a.ph_lo = 0; a.ph_hi = N_PHASES; a.li = 0; hipLaunchKernelGGL(fwd_kernel, dim3(grid), dim3(512), LDS_BYTES, stream, a); }
    else for (int li = 0; li < N_PHASES; ++li) { a.ph_lo = li; a.ph_hi = li + 1; a.li = li; hipLaunchKernelGGL(fwd_kernel, dim3(grid), dim3(512), LDS_BYTES, stream, a); }
}
```

```cpp
#include <hip/hip_runtime.h>
#include <cstdio>
#include <cstdint>

#ifndef MK_N_LAUNCHES
#define MK_N_LAUNCHES 1
#endif
constexpr int N_PHASES = 12;
constexpr int N_LAUNCHES = MK_N_LAUNCHES;

constexpr int NB = 4, SEQ = 4096, LCX = 256, DM = 1024, FF = 4096;
constexpr int ML = NB * SEQ;
constexpr int MC = NB * LCX;
constexpr int MT = ML + MC;
constexpr int NIN = 4608;
constexpr int RWP = 1792;
constexpr int RWW = 1696;
constexpr int NHR = 8;
constexpr float NORM_EPS = 1e-6f, LNX_EPS = 64e-5f;
constexpr float QSCALE = 0.125f * 1.4426950408889634f;
constexpr float LOG2E = 1.4426950408889634f;

constexpr size_t MiB = 1u << 20;
constexpr size_t WS_CTL = 0, CTL_ZERO_BYTES = 1 * MiB;
constexpr size_t WS_MOD = 1 * MiB;
constexpr size_t WS_CB = 1 * MiB + 256 * 1024;
constexpr size_t WS_WLORA = 1 * MiB + 512 * 1024;
constexpr size_t WS_ROPE = 2 * MiB;
constexpr size_t WS_SS1 = 3 * MiB;
constexpr size_t WS_SS2 = 4 * MiB;
constexpr size_t WS_HGS = 5 * MiB;
constexpr size_t WS_WA = 8 * MiB, WS_WR = 9 * MiB, WS_WO = 10 * MiB, WS_WU = 12 * MiB, WS_WD = 20 * MiB, WS_WIN = 28 * MiB;
constexpr size_t WS_RW = 40 * MiB;
constexpr size_t WS_Z0 = 40 * MiB;
constexpr size_t WS_YRW = 72 * MiB;
constexpr size_t WS_YA = 100 * MiB;
constexpr size_t WS_HB = 116 * MiB;
constexpr size_t WS_Q = 150 * MiB;
constexpr size_t WS_K = 166 * MiB;
constexpr size_t WS_V = 171 * MiB;
constexpr size_t WS_R1L = 116 * MiB;
constexpr size_t WS_R1C = 244 * MiB;
constexpr size_t WS_M1 = 168 * MiB;
constexpr size_t WS_A2 = 200 * MiB;
constexpr size_t WS_U = 40 * MiB;
constexpr size_t WS_END = 256 * MiB;
static_assert(WS_R1L + (size_t)2048 * 65536 <= WS_R1C && WS_R1C + (size_t)128 * 32768 <= WS_END && WS_Z0 + (size_t)64 * 64 * 8192 <= WS_YRW, "rwkv tiles fit");
static_assert(WS_RW + (size_t)MT * RWP * 2 <= WS_YA && WS_YA + (size_t)ML * 512 * 2 <= WS_HB, "map");
static_assert(WS_HB + (size_t)MT * DM * 2 <= WS_Q && WS_K + (size_t)MT * 128 * 2 <= WS_V, "map");
static_assert(WS_U + (size_t)ML * FF * 2 <= WS_M1 && WS_M1 + (size_t)ML * DM * 2 <= WS_A2 && WS_A2 + (size_t)ML * DM * 2 <= WS_END, "map");

constexpr int RING_BYTES = 131072;
constexpr int LDSCTL_OFF = RING_BYTES, MISC_OFF = LDSCTL_OFF + 320;
constexpr int LDS_BYTES = 163840;

#define GAS __attribute__((address_space(1)))
#define LAS __attribute__((address_space(3)))
typedef unsigned short bf16;
typedef unsigned v4u __attribute__((ext_vector_type(4)));
typedef unsigned v2u __attribute__((ext_vector_type(2)));
typedef float f32x4 __attribute__((ext_vector_type(4)));
typedef float f32x2 __attribute__((ext_vector_type(2)));
typedef float f32x16 __attribute__((ext_vector_type(16)));
typedef short bf16x8 __attribute__((ext_vector_type(8)));
typedef GAS unsigned gu32;
typedef GAS unsigned long long gu64;
#define RLX_AGENT __ATOMIC_RELAXED, __HIP_MEMORY_SCOPE_AGENT
#define LDS_WAIT() asm volatile("s_waitcnt lgkmcnt(0)" ::: "memory")
#define VM_WAIT() asm volatile("s_waitcnt vmcnt(0)" ::: "memory")

__device__ __forceinline__ unsigned f2bf(float f) { unsigned u = __builtin_bit_cast(unsigned, f); return (u + 0x7fffu + ((u >> 16) & 1u)) >> 16; }
__device__ __forceinline__ unsigned pk2(float lo, float hi) { return f2bf(lo) | (f2bf(hi) << 16); }
__device__ __forceinline__ float bf_lo(unsigned w) { return __builtin_bit_cast(float, w << 16); }
__device__ __forceinline__ float bf_hi(unsigned w) { return __builtin_bit_cast(float, w & 0xffff0000u); }
__device__ __forceinline__ float bf2f(bf16 h) { return __builtin_bit_cast(float, (unsigned)h << 16); }
__device__ __forceinline__ float fast_rcp(float x) { return __builtin_amdgcn_rcpf(x); }
__device__ __forceinline__ float fast_exp(float x) { return __builtin_amdgcn_exp2f(x * LOG2E); }
__device__ __forceinline__ float sigmoidf_(float x) { return fast_rcp(1.0f + fast_exp(-x)); }
template <int CTRL> __device__ __forceinline__ float dppf(float v) { return __builtin_bit_cast(float, __builtin_amdgcn_update_dpp(0, __builtin_bit_cast(int, v), CTRL, 0xf, 0xf, true)); }
__device__ __forceinline__ float red16(float x) {
    x += dppf<0xB1>(x); x += dppf<0x4E>(x); x += dppf<0x141>(x); x += dppf<0x140>(x); return x; }
__device__ __forceinline__ float rdlane(float v, int l) { return __builtin_bit_cast(float, __builtin_amdgcn_readlane(__builtin_bit_cast(int, v), l)); }
__device__ __forceinline__ float wave_sum(float x) { x = red16(x); return (rdlane(x, 0) + rdlane(x, 16)) + (rdlane(x, 32) + rdlane(x, 48)); }
namespace pg8 {
#define PG8_LAS __attribute__((address_space(3)))
typedef unsigned short bf16_t;
typedef short bf16x8 __attribute__((ext_vector_type(8)));
typedef float f32x4 __attribute__((ext_vector_type(4)));
typedef unsigned u32x4 __attribute__((ext_vector_type(4)));
constexpr int BM = 256, BK = 64, HALF = 128, HTB = HALF * BK * 2  , STAGE_BYTES = 8 * HTB, NXCD = 8, WGM = 8;

__host__ __device__ __forceinline__ int lds_byte(int r, int c) { const int st = (r >> 4) * 2 + (c >> 5), rr = r & 15, cc = c & 31, ob = rr * 64 + cc * 2; return st * 1024 + (ob ^ (((ob >> 9) & 1) << 5)); }
__host__ __device__ __forceinline__ void stage_rc(int b, int& R, int& C) { const int st = b / 1024, sb = b % 1024, swz = sb ^ (((sb >> 9) & 1) << 5); R = (st >> 1) * 16 + swz / 64; C = (st & 1) * 32 + (swz % 64) / 2; }
__host__ __device__ __forceinline__ int perm32(int rho) { const int n = rho >> 4, i = rho & 15; return 8 * (i >> 2) + 4 * n + (i & 3); }

struct Unit { int pm, pn; };
struct Gemm { const bf16_t* A; const bf16_t* Bt; int M, N, K; };

struct StaticOrder {
    int nM, nN, nwg, G, c;
    __host__ __device__ void init(int M, int N, int G_, int c_) { nM = M / BM; nN = N / BM; nwg = nM * nN; G = G_; c = c_; }
    __host__ __device__ bool next(int i, Unit& u) const {
        const long L = (long)i * G + c; if (L >= nwg) return false;
        int wgid = (int)L; { const int q = nwg / NXCD, r = nwg % NXCD, xcd = wgid % NXCD, off = wgid / NXCD; wgid = (xcd < r ? xcd * (q + 1) : r * (q + 1) + (xcd - r) * q) + off; }
        const int nig = WGM * nN, gid = wgid / nig, fm = gid * WGM, gsz = (nM - fm) < WGM ? (nM - fm) : WGM;
        u.pm = fm + ((wgid % nig) % gsz); u.pn = (wgid % nig) / gsz; return true;
    }
    __device__ __forceinline__ void a_ready(const Unit&) const {}
    __device__ __forceinline__ void done(const Unit&) const {}
};

typedef unsigned u32x2 __attribute__((ext_vector_type(2)));

struct OrderX {
    int nM, nN, nwg, G, c, nextra, ex_pm0, ex_npm, ex_pn0;
    __device__ void init(int M, int N, int G_, int c_, int nextra_ = 0, int ex_pm0_ = 0, int ex_npm_ = 1, int ex_pn0_ = 0) {
        nM = M / BM; nN = N / BM; nwg = nM * nN; G = G_; c = c_; nextra = nextra_; ex_pm0 = ex_pm0_; ex_npm = ex_npm_; ex_pn0 = ex_pn0_; }
    __device__ bool next(int i, Unit& u) const {
        const long L = (long)i * G + c; if (L >= nwg + nextra) return false;
        if (L >= nwg) { const int e = (int)L - nwg; u.pm = ex_pm0 + e % ex_npm; u.pn = ex_pn0 + e / ex_npm; return true; }
        int wgid = (int)L; { const int q = nwg / NXCD, r = nwg % NXCD, xcd = wgid % NXCD, off = wgid / NXCD; wgid = (xcd < r ? xcd * (q + 1) : r * (q + 1) + (xcd - r) * q) + off; }
        const int nig = WGM * nN, gid = wgid / nig, fm = gid * WGM, gsz = (nM - fm) < WGM ? (nM - fm) : WGM;
        u.pm = fm + ((wgid % nig) % gsz); u.pn = (wgid % nig) / gsz; return true;
    }
    __device__ __forceinline__ void a_ready(const Unit&) const {}
    __device__ __forceinline__ void done(const Unit&) const {}
};

typedef float cv_f32x2 __attribute__((ext_vector_type(2))); typedef __bf16 cv_bf16x2 __attribute__((ext_vector_type(2)));
__device__ __forceinline__ unsigned cvt_pk_bf16(float lo, float hi) { cv_f32x2 v = {lo, hi}; cv_bf16x2 b = __builtin_convertvector(v, cv_bf16x2); return __builtin_bit_cast(unsigned, b); }
__device__ __forceinline__ float e_rcp(float x) { return __builtin_amdgcn_rcpf(x); }
__device__ __forceinline__ float e_sigmoid(float x) { return e_rcp(1.0f + __builtin_amdgcn_exp2f(x * -1.4426950408889634f)); }
__device__ __forceinline__ float e_lo(unsigned w) { return __builtin_bit_cast(float, w << 16); }
__device__ __forceinline__ float e_hi(unsigned w) { return __builtin_bit_cast(float, w & 0xffff0000u); }

struct EpiInProj {
    static constexpr bool PERM = true, AFTER_DRAIN = false;
    bf16_t *Q, *Kb, *Vb, *RW, *GATE; const float *COS, *SIN; float qscale;
    __device__ __forceinline__ void operator()(const f32x4 (&acc)[2][2][4][2], const Unit& u, int wr, int wc, int fr, int fq) const {
        const int row0 = u.pm * BM + wr * 64 + fr;
#pragma unroll
        for (int bj = 0; bj < 2; ++bj) {
            const int c0 = u.pn * BM + bj * HALF + wc * 32 + 8 * fq;
#pragma unroll
            for (int ai = 0; ai < 2; ++ai)
#pragma unroll
                for (int m = 0; m < 4; ++m) {
                    const int r = row0 + ai * HALF + m * 16;
                    f32x4 v0 = acc[ai][bj][m][0], v1 = acc[ai][bj][m][1];
                    u32x4 w;
                    if (c0 < 640) {
                        if (r < 16384) {
                            const int pos = r & 4095, ip = (c0 & 63) >> 1;
                            const f32x4 cs = *(const f32x4*)(COS + pos * 32 + ip), sn = *(const f32x4*)(SIN + pos * 32 + ip);
                            const f32x4 a = v0, b = v1;
                            v0[0] = a[0] * cs[0] - a[1] * sn[0]; v0[1] = a[0] * sn[0] + a[1] * cs[0];
                            v0[2] = a[2] * cs[1] - a[3] * sn[1]; v0[3] = a[2] * sn[1] + a[3] * cs[1];
                            v1[0] = b[0] * cs[2] - b[1] * sn[2]; v1[1] = b[0] * sn[2] + b[1] * cs[2];
                            v1[2] = b[2] * cs[3] - b[3] * sn[3]; v1[3] = b[2] * sn[3] + b[3] * cs[3];
                        }
                        if (c0 < 512) { v0 = v0 * qscale; v1 = v1 * qscale; }
                        w.x = cvt_pk_bf16(v0[0], v0[1]); w.y = cvt_pk_bf16(v0[2], v0[3]); w.z = cvt_pk_bf16(v1[0], v1[1]); w.w = cvt_pk_bf16(v1[2], v1[3]);
                        if (c0 < 512) *(u32x4*)(Q + (size_t)r * 512 + c0) = w;
                        else *(u32x4*)(Kb + (size_t)r * 128 + (c0 - 512)) = w;
                    } else if (c0 < 768) {
                        w.x = cvt_pk_bf16(v0[0], v0[1]); w.y = cvt_pk_bf16(v0[2], v0[3]); w.z = cvt_pk_bf16(v1[0], v1[1]); w.w = cvt_pk_bf16(v1[2], v1[3]);
                        *(u32x4*)(Vb + (size_t)r * 128 + (c0 - 640)) = w;
                    } else if (c0 < 2560) {
                        w.x = cvt_pk_bf16(v0[0], v0[1]); w.y = cvt_pk_bf16(v0[2], v0[3]); w.z = cvt_pk_bf16(v1[0], v1[1]); w.w = cvt_pk_bf16(v1[2], v1[3]);
                        *(u32x4*)(RW + (size_t)r * 1792 + (c0 - 768)) = w;
                    } else {
                        w.x = cvt_pk_bf16(e_sigmoid(v0[0]), e_sigmoid(v0[1])); w.y = cvt_pk_bf16(e_sigmoid(v0[2]), e_sigmoid(v0[3]));
                        w.z = cvt_pk_bf16(e_sigmoid(v1[0]), e_sigmoid(v1[1])); w.w = cvt_pk_bf16(e_sigmoid(v1[2]), e_sigmoid(v1[3]));
                        *(u32x4*)(GATE + (size_t)r * 2048 + (c0 - 2560)) = w;
                    }
                }
        }
    }
};

template <int MODE> struct EpiBranch {
    static constexpr bool PERM = true, AFTER_DRAIN = false;
    bf16_t* GATE; bf16_t* M1;
    __device__ __forceinline__ void operator()(const f32x4 (&acc)[2][2][4][2], const Unit& u, int wr, int wc, int fr, int fq) const {
        const int row0 = u.pm * BM + wr * 64 + fr;
#pragma unroll
        for (int ai = 0; ai < 2; ++ai)
#pragma unroll
            for (int m = 0; m < 4; ++m) {
                const int r = row0 + ai * HALF + m * 16;
#pragma unroll
                for (int bj = 0; bj < 2; ++bj) {
                    const int c0 = u.pn * BM + bj * HALF + wc * 32 + 8 * fq;
                    const f32x4 v0 = acc[ai][bj][m][0], v1 = acc[ai][bj][m][1];
                    bf16_t* gp = GATE + (size_t)r * 2048 + c0;
                    u32x4 w;
                    if (MODE == 0) {
                        const u32x4 g = *(const u32x4*)gp;
                        w.x = cvt_pk_bf16(e_lo(g.x) * v0[0], e_hi(g.x) * v0[1]); w.y = cvt_pk_bf16(e_lo(g.y) * v0[2], e_hi(g.y) * v0[3]);
                        w.z = cvt_pk_bf16(e_lo(g.z) * v1[0], e_hi(g.z) * v1[1]); w.w = cvt_pk_bf16(e_lo(g.w) * v1[2], e_hi(g.w) * v1[3]);
                        *(u32x4*)gp = w;
                    } else {
                        const u32x4 t = *(const u32x4*)gp; const u32x4 g = *(const u32x4*)(gp + 1024);
                        w.x = cvt_pk_bf16(e_lo(t.x) + e_lo(g.x) * v0[0], e_hi(t.x) + e_hi(g.x) * v0[1]); w.y = cvt_pk_bf16(e_lo(t.y) + e_lo(g.y) * v0[2], e_hi(t.y) + e_hi(g.y) * v0[3]);
                        w.z = cvt_pk_bf16(e_lo(t.z) + e_lo(g.z) * v1[0], e_hi(t.z) + e_hi(g.z) * v1[1]); w.w = cvt_pk_bf16(e_lo(t.w) + e_lo(g.w) * v1[2], e_hi(t.w) + e_hi(g.w) * v1[3]);
                        *(u32x4*)(M1 + (size_t)r * 1024 + c0) = w;
                    }
                }
            }
    }
};

template <int MODE> struct EpiResid {
    static constexpr bool PERM = false, AFTER_DRAIN = false;
    const float* XIN; float* X1; bf16_t* A2; const float* MOD; const float* g2; float* SS; int gate_off;
    __device__ __forceinline__ void operator()(const f32x4 (&acc)[2][2][4][2], const Unit& u, int wr, int wc, int fr, int fq) const {
        const int row0 = u.pm * BM + wr * 64 + fr;
        const int b = (u.pm * BM) >> 12;
        const float* modb = MOD + b * 6144;
        const int colw = u.pn * BM + wc * 32 + 4 * fq;
        f32x4 gt[2][2], gc[2][2];
#pragma unroll
        for (int bj = 0; bj < 2; ++bj)
#pragma unroll
            for (int n = 0; n < 2; ++n) {
                const int c = colw + bj * HALF + n * 16;
                gt[bj][n] = *(const f32x4*)(modb + gate_off + c);
                if (MODE == 0) { const f32x4 sc = *(const f32x4*)(modb + 4 * 1024 + c); const f32x4 gg = *(const f32x4*)(g2 + c); gc[bj][n] = gg * (sc + 1.0f); }
            }
#pragma unroll
        for (int ai = 0; ai < 2; ++ai)
#pragma unroll
            for (int m = 0; m < 4; ++m) {
                const int r = row0 + ai * HALF + m * 16;
                float ss = 0.f;
#pragma unroll
                for (int bj = 0; bj < 2; ++bj)
#pragma unroll
                    for (int n = 0; n < 2; ++n) {
                        const int c = colw + bj * HALF + n * 16;
                        const f32x4 xi = *(const f32x4*)(XIN + (size_t)r * 1024 + c);
                        const f32x4 x1 = xi + gt[bj][n] * acc[ai][bj][m][n];
                        *(f32x4*)(X1 + (size_t)r * 1024 + c) = x1;
                        ss += (x1[0] * x1[0] + x1[1] * x1[1]) + (x1[2] * x1[2] + x1[3] * x1[3]);
                        if (MODE == 0) { const f32x4 a = x1 * gc[bj][n]; u32x2 w; w.x = cvt_pk_bf16(a[0], a[1]); w.y = cvt_pk_bf16(a[2], a[3]); *(u32x2*)(A2 + (size_t)r * 1024 + c) = w; }
                    }
                ss += __shfl_xor(ss, 16); ss += __shfl_xor(ss, 32);
                if (fq == 0) SS[(size_t)(u.pn * 4 + wc) * 16384 + r] = ss;
            }
    }
};

struct EpiUp {
    static constexpr bool PERM = true, AFTER_DRAIN = false;
    bf16_t* U; const float* SS; const float* CB;
    __device__ __forceinline__ void operator()(const f32x4 (&acc)[2][2][4][2], const Unit& u, int wr, int wc, int fr, int fq) const {
        const int row0 = u.pm * BM + wr * 64 + fr;
        const int b = (u.pm * BM) >> 12;
        f32x4 cb[2][2];
#pragma unroll
        for (int bj = 0; bj < 2; ++bj)
#pragma unroll
            for (int n = 0; n < 2; ++n) cb[bj][n] = *(const f32x4*)(CB + b * 4096 + u.pn * BM + bj * HALF + wc * 32 + 8 * fq + 4 * n);
#pragma unroll
        for (int ai = 0; ai < 2; ++ai)
#pragma unroll
            for (int m = 0; m < 4; ++m) {
                const int r = row0 + ai * HALF + m * 16;
                float s = 0.f;
#pragma unroll
                for (int p = 0; p < 16; ++p) s += SS[(size_t)p * 16384 + r];
                const float rs = __builtin_amdgcn_rsqf(s * (1.0f / 1024.0f) + 1e-6f);
#pragma unroll
                for (int bj = 0; bj < 2; ++bj) {
                    const int c0 = u.pn * BM + bj * HALF + wc * 32 + 8 * fq;
                    f32x4 v0 = acc[ai][bj][m][0] * rs + cb[bj][0], v1 = acc[ai][bj][m][1] * rs + cb[bj][1];
#pragma unroll
                    for (int e = 0; e < 4; ++e) { const float a = v0[e] > 0.f ? v0[e] : 0.f; v0[e] = a * a; const float c = v1[e] > 0.f ? v1[e] : 0.f; v1[e] = c * c; }
                    u32x4 w; w.x = cvt_pk_bf16(v0[0], v0[1]); w.y = cvt_pk_bf16(v0[2], v0[3]); w.z = cvt_pk_bf16(v1[0], v1[1]); w.w = cvt_pk_bf16(v1[2], v1[3]);
                    *(u32x4*)(U + (size_t)r * 4096 + c0) = w;
                }
            }
    }
};
template <class Epi, class Sched, bool ALIGN_EPI = false, bool SP2 = false>
__device__ __forceinline__ void gemm_phase(PG8_LAS unsigned char* lds, const Gemm g, const Sched& S, const Epi& E) {
    const int tid = threadIdx.x, wid = __builtin_amdgcn_readfirstlane(tid >> 6), lane = tid & 63, wr = wid >> 2, wc = wid & 3, fr = lane & 15, fq = lane >> 4;
    const int K = g.K, nt = K / BK;
    unsigned voffA[2], voffB[2];
#pragma unroll
    for (int i = 0; i < 2; ++i) { int R, C; stage_rc(tid * 16 + i * 8192, R, C); const int Rb = Epi::PERM ? ((R & ~31) + perm32(R & 31)) : R;
        voffA[i] = (unsigned)(R * K + C) * 2u; voffB[i] = (unsigned)(Rb * K + C) * 2u; }
    const size_t kstep = (size_t)(BK * 2);
    const size_t hstep = (size_t)HALF * K * 2;
    const size_t tstep = 2 * hstep;
    const unsigned ldsw = (unsigned)wid * 1024u;
    const int aoff = lds_byte(wr * 64 + fr, fq * 8), boff = lds_byte(wc * 32 + fr, fq * 8);
#define PG8_SA(b, h) (((b) * 2 + (h)) * HTB)
#define PG8_SB(b, h) ((4 + (b) * 2 + (h)) * HTB)
#define PG8_STAGE(bufoff, gbase, voff) do { _Pragma("unroll") for (int _i = 0; _i < 2; ++_i) \
        __builtin_amdgcn_global_load_lds((const unsigned*)((const char*)(gbase) + (voff)[_i]), (PG8_LAS unsigned*)(lds + (bufoff) + ldsw + _i * 8192), 16, 0, 0); } while (0)
#define PG8_LDA(dst, b, h) do { _Pragma("unroll") for (int m = 0; m < 4; ++m) _Pragma("unroll") for (int k = 0; k < 2; ++k) dst[m][k] = *(const PG8_LAS bf16x8*)(lds + PG8_SA(b, h) + aoff + m * 2048 + k * 1024); } while (0)
#define PG8_LDB(dst, b, h) do { _Pragma("unroll") for (int n = 0; n < 2; ++n) _Pragma("unroll") for (int k = 0; k < 2; ++k) dst[n][k] = *(const PG8_LAS bf16x8*)(lds + PG8_SB(b, h) + boff + n * 2048 + k * 1024); } while (0)
#define PG8_MMA(ai, bj, At, Bt) do { __builtin_amdgcn_s_setprio(1); _Pragma("unroll") for (int m = 0; m < 4; ++m) _Pragma("unroll") for (int n = 0; n < 2; ++n) _Pragma("unroll") for (int k = 0; k < 2; ++k) \
        acc[ai][bj][m][n] = __builtin_amdgcn_mfma_f32_16x16x32_bf16(Bt[n][k], At[m][k], acc[ai][bj][m][n], 0, 0, 0); __builtin_amdgcn_s_setprio(0); } while (0)
#define PG8_WAIT_V(n) asm volatile("s_waitcnt vmcnt(" #n ")" ::: "memory")
#define PG8_WAIT_L(n) asm volatile("s_waitcnt lgkmcnt(" #n ")" ::: "memory")
#define PG8_BAR __builtin_amdgcn_s_barrier()
#define PG8_SCHED __builtin_amdgcn_sched_barrier(0)
    Unit cur, nxt; int ui = 0;
    if (!S.next(0, cur)) return;
    f32x4 acc[2][2][4][2];
#pragma unroll
    for (int a = 0; a < 2; ++a)
#pragma unroll
        for (int b = 0; b < 2; ++b)
#pragma unroll
            for (int m = 0; m < 4; ++m)
#pragma unroll
                for (int n = 0; n < 2; ++n) acc[a][b][m][n] = (f32x4){0.f, 0.f, 0.f, 0.f};
    bf16x8 At[4][2], B0[2][2], B1[2][2];
    const char* cA = (const char*)g.A + (size_t)cur.pm * tstep; const char* cB = (const char*)g.Bt + (size_t)cur.pn * tstep;
    S.a_ready(cur);
    if constexpr (SP2) {
        PG8_STAGE(PG8_SB(0, 0), cB, voffB); PG8_STAGE(PG8_SB(0, 1), cB + hstep, voffB); PG8_STAGE(PG8_SA(0, 0), cA, voffA); PG8_STAGE(PG8_SA(0, 1), cA + hstep, voffA);
        if (wr == 1) PG8_BAR;
        PG8_WAIT_V(2); PG8_BAR;
        PG8_STAGE(PG8_SB(1, 0), cB + kstep, voffB); PG8_STAGE(PG8_SA(1, 0), cA + kstep, voffA); PG8_STAGE(PG8_SB(1, 1), cB + hstep + kstep, voffB);
        PG8_WAIT_V(6); PG8_BAR;
    } else {
        PG8_STAGE(PG8_SB(0, 0), cB, voffB); PG8_STAGE(PG8_SA(0, 0), cA, voffA); PG8_STAGE(PG8_SB(0, 1), cB + hstep, voffB); PG8_STAGE(PG8_SA(0, 1), cA + hstep, voffA);
        if (wr == 1) PG8_BAR;
        PG8_WAIT_V(4); PG8_BAR;
        PG8_STAGE(PG8_SB(1, 0), cB + kstep, voffB); PG8_STAGE(PG8_SA(1, 0), cA + kstep, voffA); PG8_STAGE(PG8_SB(1, 1), cB + hstep + kstep, voffB);
        PG8_WAIT_V(6); PG8_BAR;
    }
    for (;;) {
        const bool has_next = S.next(ui + 1, nxt);
        const char* nA = has_next ? (const char*)g.A + (size_t)nxt.pm * tstep : cA; const char* nB = has_next ? (const char*)g.Bt + (size_t)nxt.pn * tstep : cB;
        for (int t = 0; t < nt; t += 2) {
            const bool last = (t == nt - 2);
            const char* a1 = cA + (size_t)(t + 1) * kstep;
            const char* a2 = last ? nA : cA + (size_t)(t + 2) * kstep; const char* b2 = last ? nB : cB + (size_t)(t + 2) * kstep;
            const char* a3 = a2 + kstep; const char* b3 = b2 + kstep;
            if (last && has_next) S.a_ready(nxt);
            if constexpr (SP2) {
            PG8_LDB(B0, 0, 0); PG8_LDB(B1, 0, 1); PG8_SCHED; PG8_LDA(At, 0, 0); PG8_STAGE(PG8_SA(1, 1), a1 + hstep, voffA);
            PG8_WAIT_V(8); PG8_WAIT_L(0); PG8_BAR; PG8_MMA(0, 0, At, B0); PG8_MMA(0, 1, At, B1); PG8_BAR; PG8_SCHED;
            PG8_LDA(At, 0, 1); PG8_STAGE(PG8_SB(0, 0), b2, voffB); PG8_STAGE(PG8_SB(0, 1), b2 + hstep, voffB); PG8_STAGE(PG8_SA(0, 0), a2, voffA);
            PG8_WAIT_V(8); PG8_WAIT_L(0); PG8_BAR; PG8_MMA(1, 0, At, B0); PG8_MMA(1, 1, At, B1); PG8_BAR; PG8_SCHED;
            PG8_LDB(B0, 1, 0); PG8_LDB(B1, 1, 1); PG8_SCHED; PG8_LDA(At, 1, 0); PG8_STAGE(PG8_SA(0, 1), a2 + hstep, voffA);
            PG8_WAIT_V(8); PG8_WAIT_L(0); PG8_BAR; PG8_MMA(0, 0, At, B0); PG8_MMA(0, 1, At, B1); PG8_BAR; PG8_SCHED;
            PG8_LDA(At, 1, 1); PG8_STAGE(PG8_SB(1, 0), b3, voffB); PG8_STAGE(PG8_SB(1, 1), b3 + hstep, voffB); PG8_STAGE(PG8_SA(1, 0), a3, voffA);
            PG8_WAIT_V(8); PG8_WAIT_L(0); PG8_BAR; PG8_MMA(1, 0, At, B0); PG8_MMA(1, 1, At, B1); PG8_BAR; PG8_SCHED;
            } else {
            PG8_LDB(B0, 0, 0); PG8_SCHED; PG8_LDA(At, 0, 0); PG8_STAGE(PG8_SA(1, 1), a1 + hstep, voffA);
            PG8_WAIT_L(8); PG8_BAR; PG8_WAIT_L(0); PG8_MMA(0, 0, At, B0); PG8_BAR; PG8_SCHED;
            PG8_LDB(B1, 0, 1); PG8_STAGE(PG8_SB(0, 0), b2, voffB);
            PG8_BAR; PG8_WAIT_L(0); PG8_MMA(0, 1, At, B1); PG8_BAR;
            PG8_LDA(At, 0, 1); PG8_STAGE(PG8_SA(0, 0), a2, voffA);
            PG8_BAR; PG8_WAIT_L(0); PG8_MMA(1, 0, At, B0); PG8_BAR; PG8_SCHED;
            PG8_STAGE(PG8_SB(0, 1), b2 + hstep, voffB);
            PG8_WAIT_V(6); PG8_BAR; PG8_MMA(1, 1, At, B1); PG8_BAR;
            PG8_LDB(B0, 1, 0); PG8_SCHED; PG8_LDA(At, 1, 0); PG8_STAGE(PG8_SA(0, 1), a2 + hstep, voffA);
            PG8_WAIT_L(8); PG8_BAR; PG8_WAIT_L(0); PG8_MMA(0, 0, At, B0); PG8_BAR; PG8_SCHED;
            PG8_LDB(B1, 1, 1); PG8_STAGE(PG8_SB(1, 0), b3, voffB);
            PG8_BAR; PG8_WAIT_L(0); PG8_MMA(0, 1, At, B1); PG8_BAR;
            PG8_LDA(At, 1, 1); PG8_STAGE(PG8_SA(1, 0), a3, voffA);
            PG8_BAR; PG8_WAIT_L(0); PG8_MMA(1, 0, At, B0); PG8_BAR; PG8_SCHED;
            PG8_STAGE(PG8_SB(1, 1), b3 + hstep, voffB);
            PG8_WAIT_V(6); PG8_BAR; PG8_MMA(1, 1, At, B1); PG8_BAR;
            }
        }
        if constexpr (ALIGN_EPI) { if (wr == 0) PG8_BAR; }
        if constexpr (!Epi::AFTER_DRAIN) { E(acc, cur, wr, wc, fr, fq); S.done(cur); }
        if (!has_next) break;
#pragma unroll
        for (int a = 0; a < 2; ++a)
#pragma unroll
            for (int b = 0; b < 2; ++b)
#pragma unroll
                for (int m = 0; m < 4; ++m)
#pragma unroll
                    for (int n = 0; n < 2; ++n) acc[a][b][m][n] = (f32x4){0.f, 0.f, 0.f, 0.f};
        cur = nxt; cA = nA; cB = nB; ++ui;
        if constexpr (ALIGN_EPI) { if (wr == 1) PG8_BAR; }
    }
    PG8_WAIT_V(0);
    if constexpr (!ALIGN_EPI) { if (wr == 0) PG8_BAR; }
    PG8_BAR;
    if constexpr (Epi::AFTER_DRAIN) { E.fused(acc, cur, wr, wc, fr, fq, lds, wid, lane); S.done(cur); }
#undef PG8_SA
#undef PG8_SB
#undef PG8_STAGE
#undef PG8_LDA
#undef PG8_LDB
#undef PG8_MMA
#undef PG8_WAIT_V
#undef PG8_WAIT_L
#undef PG8_BAR
#undef PG8_SCHED
}
}

namespace att {
typedef short s16x4 __attribute__((ext_vector_type(4)));
typedef short v4i16_t __attribute__((ext_vector_type(4)));
constexpr int SLOTB = 8192;
constexpr int LDS_K = 0, LDS_V = 2 * SLOTB, LDS_WS = 4 * SLOTB, LDS_OST = LDS_WS + 8 * 256, LDS_TOT = LDS_OST + 8 * 4096;
__device__ __forceinline__ int crow(int r, int hi) { return (r & 3) + 8 * (r >> 2) + 4 * hi; }
__device__ __forceinline__ void glds16(const void* gsrc, unsigned lds_dst) { unsigned keep;
    asm volatile("s_mov_b32 %0, m0\n\ts_mov_b32 m0, %2\n\ts_nop 0\n\tglobal_load_lds_dwordx4 %1, off\n\ts_mov_b32 m0, %0" : "=&s"(keep) : "v"(gsrc), "s"(lds_dst) : "memory"); }
#define ATT_WAIT_BAR(N) asm volatile("s_waitcnt vmcnt(" #N ") lgkmcnt(0)\n\ts_barrier" ::: "memory")
typedef float cv_f32x2 __attribute__((ext_vector_type(2))); typedef __bf16 cv_bf16x2 __attribute__((ext_vector_type(2)));
__device__ __forceinline__ unsigned cvtpk(float lo, float hi) { cv_f32x2 v = {lo, hi}; cv_bf16x2 b = __builtin_convertvector(v, cv_bf16x2); return __builtin_bit_cast(unsigned, b); }

__device__ __forceinline__ void attn_unit(int b, int g, int qb, const bf16* Q, const bf16* Kb, const bf16* Vb, bf16* O, const float* sink, LAS unsigned char* shm) {
    const int tid = threadIdx.x, lane = tid & 63, r32 = lane & 31, hi = lane >> 5; const int wid = __builtin_amdgcn_readfirstlane(tid >> 6);
    const int hq = g * 4 + (wid >> 1);
    const int qrel = (wid & 1) * 32 + r32;
    const size_t qrow0 = (size_t)b * 4096 + (size_t)qb * 64 + (wid & 1) * 32;
    const unsigned lds0 = (unsigned)(uintptr_t)shm;
    LAS float* wsf = (LAS float*)(shm + LDS_WS) + wid * 64;
    const int jlo = qb == 0 ? 2 : (qb == 1 ? 1 : 0), jhi = (65 - qb) < 4 ? (65 - qb) : 4, nloc = jhi - jlo + 1, NT = nloc + 4;
    const unsigned kdst = lds0 + LDS_K + wid * 1024, vdst = lds0 + LDS_V + wid * 1024;
    const bf16* kbase = Kb + (size_t)lane * 128 + g * 64 + wid * 8;
    const bf16* vbase = Vb + (size_t)(16 * (wid & 3) + (lane >> 2)) * 128 + g * 64 + (wid >> 2) * 32 + (lane & 3) * 8;
#define ATT_ROWBASE(t) ((t) < nloc ? ((size_t)b * 4096 + (size_t)(64 * (qb + jlo + (t) - 2))) : ((size_t)16384 + (size_t)b * 256 + (size_t)(64 * ((t) - nloc))))
#define ATT_DMA(t, slot) do { const size_t rb_ = ATT_ROWBASE(t); glds16(kbase + rb_ * 128, (unsigned)__builtin_amdgcn_readfirstlane(kdst + (slot) * SLOTB)); \
                              glds16(vbase + rb_ * 128, (unsigned)__builtin_amdgcn_readfirstlane(vdst + (slot) * SLOTB)); } while (0)
    ATT_DMA(0, 0);
    bf16x8 qr[4];
#pragma unroll
    for (int d0 = 0; d0 < 4; ++d0) qr[d0] = *(const bf16x8*)(Q + (qrow0 + r32) * 512 + hq * 64 + d0 * 16 + hi * 8);
    float m_run = sink[hq] * LOG2E, l_reg = hi == 0 ? 1.0f : 0.0f;
    f32x16 o[2]; o[0] = f32x16{}; o[1] = f32x16{};
    const int vb0 = (int)(lds0 + LDS_V) + ((lane >> 4) & 1) * 32 + (lane & 3) * 8 + (4 * hi + ((lane & 15) >> 2)) * 64;
    for (int t = 0; t < NT; ++t) {
        const int slot = t & 1;
        if (t + 1 < NT) { ATT_DMA(t + 1, slot ^ 1); ATT_WAIT_BAR(2); } else { ATT_WAIT_BAR(0); }
        f32x16 p0 = f32x16{}, p1 = f32x16{};
        { const LAS unsigned char* kb = shm + LDS_K + slot * SLOTB + hi * 1024 + r32 * 16;
#pragma unroll
          for (int d0 = 0; d0 < 4; ++d0) {
              const bf16x8 b0 = *(const LAS bf16x8*)(kb + d0 * 2048);
              const bf16x8 b1 = *(const LAS bf16x8*)(kb + d0 * 2048 + 512);
              p0 = __builtin_amdgcn_mfma_f32_32x32x16_bf16(b0, qr[d0], p0, 0, 0, 0);
              p1 = __builtin_amdgcn_mfma_f32_32x32x16_bf16(b1, qr[d0], p1, 0, 0, 0); } }
        const int mode = (t < nloc) ? ((jlo + t) == 0 ? 1 : ((jlo + t) == 4 ? 2 : 0)) : 0;
        if (mode != 0) {
            int q_ = qrel - 4 * hi; asm volatile("" : "+v"(q_));
            if (mode == 1) {
#pragma unroll
                for (int r = 0; r < 16; ++r) { const int kr = (r & 3) + 8 * (r >> 2); if (kr < q_) p0[r] = -INFINITY; if (kr + 32 < q_) p1[r] = -INFINITY; }
            } else {
#pragma unroll
                for (int r = 0; r < 16; ++r) { const int kr = (r & 3) + 8 * (r >> 2); if (kr > q_) p0[r] = -INFINITY; if (kr + 32 > q_) p1[r] = -INFINITY; }
            }
        }
        float rm = fmaxf(p0[0], p1[0]);
#pragma unroll
        for (int r = 1; r < 16; ++r) rm = fmaxf(rm, fmaxf(p0[r], p1[r]));
        { auto rr = __builtin_amdgcn_permlane32_swap(__float_as_uint(rm), __float_as_uint(rm), false, false); rm = fmaxf(__uint_as_float(rr[0]), __uint_as_float(rr[1])); }
        const float mnew = fmaxf(m_run, rm), alpha = __builtin_amdgcn_exp2f(m_run - mnew); m_run = mnew;
        float sacc = 0.f;
#pragma unroll
        for (int r = 0; r < 16; ++r) { p0[r] = __builtin_amdgcn_exp2f(p0[r] - mnew); p1[r] = __builtin_amdgcn_exp2f(p1[r] - mnew); sacc += p0[r] + p1[r]; }
        l_reg = l_reg * alpha + sacc;
        if (hi == 0) wsf[r32] = alpha;
#pragma unroll
        for (int r = 0; r < 16; ++r) { const float f = wsf[crow(r, hi)]; o[0][r] *= f; o[1][r] *= f; }
        v4u pw[4];
#define ATT_PK(P, B) cvtpk(P[B], P[B + 1])
        pw[0] = (v4u){ATT_PK(p0, 0), ATT_PK(p0, 2), ATT_PK(p0, 4), ATT_PK(p0, 6)}; pw[1] = (v4u){ATT_PK(p0, 8), ATT_PK(p0, 10), ATT_PK(p0, 12), ATT_PK(p0, 14)};
        pw[2] = (v4u){ATT_PK(p1, 0), ATT_PK(p1, 2), ATT_PK(p1, 4), ATT_PK(p1, 6)}; pw[3] = (v4u){ATT_PK(p1, 8), ATT_PK(p1, 10), ATT_PK(p1, 12), ATT_PK(p1, 14)};
#undef ATT_PK
        { const int vb = vb0 + slot * SLOTB;
#pragma unroll
          for (int d0 = 0; d0 < 2; ++d0) { s16x4 lo[4], hh[4];
#pragma unroll
              for (int ks = 0; ks < 4; ++ks) {
                  asm volatile("ds_read_b64_tr_b16 %0,%1 offset:%c2" : "=&v"(lo[ks]) : "v"(vb), "i"(d0 * 4096 + ks * 1024) : "memory");
                  asm volatile("ds_read_b64_tr_b16 %0,%1 offset:%c2" : "=&v"(hh[ks]) : "v"(vb), "i"(d0 * 4096 + ks * 1024 + 512) : "memory"); }
              asm volatile("s_waitcnt lgkmcnt(0)" ::: "memory"); __builtin_amdgcn_sched_barrier(0);
#define ATT_VF(k) (bf16x8){lo[k][0], lo[k][1], lo[k][2], lo[k][3], hh[k][0], hh[k][1], hh[k][2], hh[k][3]}
              o[d0] = __builtin_amdgcn_mfma_f32_32x32x16_bf16(__builtin_bit_cast(bf16x8, pw[0]), ATT_VF(0), o[d0], 0, 0, 0);
              o[d0] = __builtin_amdgcn_mfma_f32_32x32x16_bf16(__builtin_bit_cast(bf16x8, pw[1]), ATT_VF(1), o[d0], 0, 0, 0);
              o[d0] = __builtin_amdgcn_mfma_f32_32x32x16_bf16(__builtin_bit_cast(bf16x8, pw[2]), ATT_VF(2), o[d0], 0, 0, 0);
              o[d0] = __builtin_amdgcn_mfma_f32_32x32x16_bf16(__builtin_bit_cast(bf16x8, pw[3]), ATT_VF(3), o[d0], 0, 0, 0);
#undef ATT_VF
          } }
        asm volatile("s_waitcnt lgkmcnt(0)\n\ts_barrier" ::: "memory");
    }
    { auto rr = __builtin_amdgcn_permlane32_swap(__float_as_uint(l_reg), __float_as_uint(l_reg), false, false); l_reg = __uint_as_float(rr[0]) + __uint_as_float(rr[1]); }
    if (hi == 0) wsf[32 + r32] = l_reg;
    float rli[16];
#pragma unroll
    for (int r = 0; r < 16; ++r) rli[r] = __builtin_amdgcn_rcpf(wsf[32 + crow(r, hi)]);
    bf16* Ow = O + qrow0 * 512 + hq * 64;
    { LAS bf16* stg = (LAS bf16*)(shm + LDS_OST) + wid * 2048;
#pragma unroll
      for (int r = 0; r < 16; ++r) { const int orow = crow(r, hi);
#pragma unroll
          for (int d0 = 0; d0 < 2; ++d0) stg[orow * 64 + d0 * 32 + r32] = (bf16)f2bf(o[d0][r] * rli[r]); }
#pragma unroll
      for (int i = 0; i < 4; ++i) { const int row = i * 8 + (lane >> 3), ch = lane & 7; const v4u v = *(const LAS v4u*)(stg + row * 64 + ch * 8); *(v4u*)(Ow + (size_t)row * 512 + ch * 8) = v; } }
    asm volatile("s_waitcnt vmcnt(0) lgkmcnt(0)\n\ts_barrier" ::: "memory");
#undef ATT_DMA
#undef ATT_ROWBASE
}
}
constexpr int CW_BAR = 4096;
#define XB_TMO      128
#define XB_XCNT(j)  (256  + 64 * (j))
#define XB_XSUB(j)  (1280 + 64 * (j))
#define XB_XGEN(j)  (2304 + 64 * (j))
#define XB_TOP      3328
#define XB_TOPGEN   3392
#define XCD_BAR_WORDS 3456
#define XB_SPIN_CAP (1u << 18)

__device__ __forceinline__ unsigned xb_ld(unsigned* p)              { return __hip_atomic_load(p, __ATOMIC_RELAXED, __HIP_MEMORY_SCOPE_AGENT); }
__device__ __forceinline__ unsigned xb_add(unsigned* p, unsigned v) { return __hip_atomic_fetch_add(p, v, __ATOMIC_RELAXED, __HIP_MEMORY_SCOPE_AGENT); }
__device__ __forceinline__ unsigned xb_xcc_id() { return (unsigned)__builtin_amdgcn_s_getreg((3 << 11) | 20) & 0xFu; }
#define XB_SPIN(cond, bar) do { unsigned _sp = 0; while (cond) { __builtin_amdgcn_s_sleep(1); \
    if ((++_sp & 255u) == 0u) { if (xb_ld(&(bar)[XB_TMO])) break; if (_sp > XB_SPIN_CAP) { atomicAdd(&(bar)[XB_TMO], 1u); break; } } } } while (0)

struct XcdBarrier {
    unsigned* bar; unsigned x;
    volatile LAS unsigned* st;
};

__device__ __forceinline__ XcdBarrier xcd_barrier_post(unsigned* bar, volatile LAS unsigned* st) {
    XcdBarrier b; b.bar = bar; b.x = xb_xcc_id(); b.st = st;
    if (threadIdx.x == 0) (void)xb_add(&bar[XB_XCNT(b.x)], 1u);
    return b;
}
__device__ __forceinline__ void xcd_barrier_complete(unsigned* bar, unsigned x, unsigned& nloc, unsigned& nx) {
    const unsigned G = gridDim.x * gridDim.y * gridDim.z;
    unsigned sum, cnt, mine, sp = 0u;
    for (;;) {
        sum = 0u; cnt = 0u; mine = 0u;
#pragma unroll
        for (unsigned j = 0; j < 16; ++j) { const unsigned c = xb_ld(&bar[XB_XCNT(j)]); sum += c; cnt += (c > 0u) ? 1u : 0u; mine = (j == x) ? c : mine; }
        if (sum == G) break;
        __builtin_amdgcn_s_sleep(1);
        if ((++sp & 255u) == 0u) { if (xb_ld(&bar[XB_TMO])) break; if (sp > XB_SPIN_CAP) { atomicAdd(&bar[XB_TMO], 1u); break; } }
    }
    nloc = mine > 0u ? mine : 1u; nx = cnt > 0u ? cnt : 1u;
}

__device__ __forceinline__ void xcd_barrier(const XcdBarrier& b) {
    asm volatile("s_waitcnt vmcnt(0)" ::: "memory");
    __syncthreads();
    if (threadIdx.x == 0) {
        unsigned* bar = b.bar;
        __builtin_amdgcn_s_waitcnt(0);
        unsigned nloc = b.st[0], nx = b.st[1];
        if (nloc == 0u) { xcd_barrier_complete(bar, b.x, nloc, nx); b.st[0] = nloc; b.st[1] = nx; }
        const unsigned old = xb_add(&bar[XB_XSUB(b.x)], 1u);
        const unsigned gen = old / nloc;
        if (old + 1u == (gen + 1u) * nloc) {
            __builtin_amdgcn_fence(__ATOMIC_RELEASE, "agent");
            asm volatile("s_waitcnt vmcnt(0)" ::: "memory");
            const unsigned og = xb_add(&bar[XB_TOP], 1u);
            const unsigned tg = og / nx;
            if (og + 1u == (tg + 1u) * nx) xb_add(&bar[XB_TOPGEN], 1u);
            else XB_SPIN(xb_ld(&bar[XB_TOPGEN]) == tg, bar);
            __builtin_amdgcn_fence(__ATOMIC_ACQUIRE, "agent");
            xb_add(&bar[XB_XGEN(b.x)], 1u);
            asm volatile("s_waitcnt vmcnt(0)" ::: "memory");
        } else {
            XB_SPIN(xb_ld(&bar[XB_XGEN(b.x)]) == gen, bar);
            __builtin_amdgcn_fence(__ATOMIC_ACQUIRE, "agent");
            asm volatile("s_waitcnt vmcnt(0)" ::: "memory");
        }
    }
    __syncthreads();
}

struct Args { const float* in[27]; float* out; unsigned char* ws; int ph_lo, ph_hi, li, pad; };
typedef __attribute__((address_space(4))) const Args* KP;
__device__ __forceinline__ KP kargs_opaque() { KP p_ = (KP)__builtin_amdgcn_kernarg_segment_ptr(); asm volatile("" : "+s"(p_)); return p_; }
__device__ __forceinline__ int opaque_i(int v) { asm volatile("" : "+s"(v)); return v; }
enum { I_X = 0, I_C, I_CTX, I_CCTX, I_WADA, I_BADA, I_N1G, I_WIN, I_SINK, I_CONVW, I_DW0, I_DW2, I_IA0, I_IA2, I_GG2, I_KK, I_KA, I_RK, I_LNXW, I_LNXB, I_WBA, I_WBR, I_WOUT, I_N2G, I_WUP, I_WDN, I_NFG };


namespace rk {
constexpr int TILE = 8192;
__device__ __forceinline__ int toff(int row, int col) { return row * 128 + ((((col >> 3) ^ (row & 7)) << 4) | ((col & 7) << 1)); }
__device__ __forceinline__ bf16x8 ldfrag(const LAS unsigned char* t, int row, int col0) { return *(const LAS bf16x8*)(t + toff(row, col0)); }
__device__ __forceinline__ unsigned pkbf(float lo, float hi) { f32x2 v = {lo, hi}; typedef __bf16 b2 __attribute__((ext_vector_type(2))); b2 b = __builtin_convertvector(v, b2); return __builtin_bit_cast(unsigned, b); }
__device__ __forceinline__ void st_nat(LAS unsigned char* t, int q, int p0, f32x4 d) { v2u w; w.x = pkbf(d[0], d[1]); w.y = pkbf(d[2], d[3]); *(LAS v2u*)(t + toff(q, p0)) = w; }
__device__ __forceinline__ void st_tr(LAS unsigned char* t, int p0, int q, f32x4 d) {
#pragma unroll
    for (int r = 0; r < 4; ++r) *(LAS bf16*)(t + toff(p0 + r, q)) = (bf16)f2bf(d[r]); }
__device__ __forceinline__ void st_gnat(bf16* g, int q, int p0, f32x4 d) { v2u w; w.x = pkbf(d[0], d[1]); w.y = pkbf(d[2], d[3]); *(v2u*)(g + q * 64 + p0) = w; }
#define RK_MFMA(a, b, c) __builtin_amdgcn_mfma_f32_16x16x32_bf16(a, b, c, 0, 0, 0)
#define RK_BAR() asm volatile("s_waitcnt lgkmcnt(0)\n\ts_barrier" ::: "memory")
template <class Epi> __device__ __forceinline__ void mm64(const LAS unsigned char* X, const LAS unsigned char* Y, int wave, int lane, const Epi& epi) {
    const int c = lane & 15, qd = lane >> 4, qt = wave & 3, pt0 = 2 * (wave >> 2);
    const bf16x8 y0 = ldfrag(Y, 16 * qt + c, 8 * qd), y1 = ldfrag(Y, 16 * qt + c, 32 + 8 * qd);
    const bf16x8 xa0 = ldfrag(X, 16 * pt0 + c, 8 * qd), xa1 = ldfrag(X, 16 * pt0 + c, 32 + 8 * qd), xb0 = ldfrag(X, 16 * pt0 + 16 + c, 8 * qd), xb1 = ldfrag(X, 16 * pt0 + 16 + c, 32 + 8 * qd);
    f32x4 da = {0.f, 0.f, 0.f, 0.f}, db = {0.f, 0.f, 0.f, 0.f};
    da = RK_MFMA(xa0, y0, da); db = RK_MFMA(xb0, y0, db); da = RK_MFMA(xa1, y1, da); db = RK_MFMA(xb1, y1, db);
    epi(pt0, qt, da, 16 * pt0 + 4 * qd, 16 * qt + c); epi(pt0 + 1, qt, db, 16 * pt0 + 16 + 4 * qd, 16 * qt + c);
}
template <class Epi> __device__ __forceinline__ void mm64_2(const LAS unsigned char* X1, const LAS unsigned char* Y1, const LAS unsigned char* X2, const LAS unsigned char* Y2, int wave, int lane, const Epi& epi) {
    const int c = lane & 15, qd = lane >> 4, qt = wave & 3, pt0 = 2 * (wave >> 2);
    const bf16x8 y0 = ldfrag(Y1, 16 * qt + c, 8 * qd), y1 = ldfrag(Y1, 16 * qt + c, 32 + 8 * qd), z0 = ldfrag(Y2, 16 * qt + c, 8 * qd), z1 = ldfrag(Y2, 16 * qt + c, 32 + 8 * qd);
    const bf16x8 xa0 = ldfrag(X1, 16 * pt0 + c, 8 * qd), xa1 = ldfrag(X1, 16 * pt0 + c, 32 + 8 * qd), xb0 = ldfrag(X1, 16 * pt0 + 16 + c, 8 * qd), xb1 = ldfrag(X1, 16 * pt0 + 16 + c, 32 + 8 * qd);
    const bf16x8 ua0 = ldfrag(X2, 16 * pt0 + c, 8 * qd), ua1 = ldfrag(X2, 16 * pt0 + c, 32 + 8 * qd), ub0 = ldfrag(X2, 16 * pt0 + 16 + c, 8 * qd), ub1 = ldfrag(X2, 16 * pt0 + 16 + c, 32 + 8 * qd);
    f32x4 da = {0.f, 0.f, 0.f, 0.f}, db = {0.f, 0.f, 0.f, 0.f};
    da = RK_MFMA(xa0, y0, da); db = RK_MFMA(xb0, y0, db); da = RK_MFMA(xa1, y1, da); db = RK_MFMA(xb1, y1, db);
    da = RK_MFMA(ua0, z0, da); db = RK_MFMA(ub0, z0, db); da = RK_MFMA(ua1, z1, da); db = RK_MFMA(ub1, z1, db);
    epi(pt0, qt, da, 16 * pt0 + 4 * qd, 16 * qt + c); epi(pt0 + 1, qt, db, 16 * pt0 + 16 + 4 * qd, 16 * qt + c);
}
constexpr float EM05 = 0.6065306597126334f;
__device__ __forceinline__ int opq(int v) { asm volatile("" : "+v"(v)); return v; }
#define RK_SLOT(n) (lds + ((n) < 16 ? (n) * rk::TILE : 132096 + ((n) - 16) * rk::TILE))
struct R1Const { const float* kk_p; const float* ka_p; const float* rk_p; const float* cw; int cg; };

struct Raw { unsigned pr[5], pk[5], pv[5], ph[5]; };
__device__ __forceinline__ void r1_unit_geom(int b, int chunk, size_t& rowbase, int& t0, int& seqlen) {
    const bool lat = chunk >= 4; const int lc = chunk - 4;
    rowbase = lat ? (size_t)b * 4096 + (size_t)lc * 64 : (size_t)16384 + (size_t)b * 256 + (size_t)chunk * 64; t0 = lat ? lc * 64 : chunk * 64; seqlen = lat ? 4096 : 256; }
__device__ __forceinline__ void r1_load_raw(Raw& R, const bf16* RW, int b, int h, int chunk, int lane, int wave) {
    size_t rowbase; int t0, seqlen; r1_unit_geom(b, chunk, rowbase, t0, seqlen);
    const int tl0 = 8 * wave, cg = h * 64 + lane;
    const bf16* zp = RW + rowbase * RWP + 1700;
    unsigned ta[10], tb[10], tc[10], td[10];
    __builtin_amdgcn_sched_barrier(0);
#pragma unroll
    for (int e = 0; e < 10; ++e) { const int t = t0 + tl0 - 1 + e; const bool ok = t >= 0 && t < seqlen; const bf16* p = RW + (rowbase + tl0 - 1 + e) * RWP;
        ta[e] = *(ok ? p + cg : zp); tb[e] = *(ok ? p + 512 + cg : zp); tc[e] = *(ok ? p + 1024 + cg : zp); td[e] = *(ok ? p + 1536 + lane : zp); }
    __builtin_amdgcn_sched_barrier(0);
#pragma unroll
    for (int j = 0; j < 5; ++j) { R.pr[j] = ta[2 * j] | (ta[2 * j + 1] << 16); R.pk[j] = tb[2 * j] | (tb[2 * j + 1] << 16); R.pv[j] = tc[2 * j] | (tc[2 * j + 1] << 16); R.ph[j] = td[2 * j] | (td[2 * j + 1] << 16); }
}
#define RK_RAW(arr, e) (((e) & 1) ? bf_hi(arr[(e) >> 1]) : bf_lo(arr[(e) >> 1]))

template <int DIR> __device__ __forceinline__ void r1_elem(LAS unsigned char* lds, const R1Const& K, const float (&rv)[8], const float (&kv)[8], const float (&vv)[8], const float (&kk)[8], bool lat, bf16* BVg, int lane_in, int wave) {
    const int lane = opq(lane_in);
    const int g = wave, tl0 = 8 * g;
    const int cgk = opq(K.cg); const float K_kac = K.ka_p[cgk], K_rkc = K.rk_p[cgk];
    LAS unsigned char* sWL = RK_SLOT(DIR == 0 ? 1 : 16); LAS unsigned char* sAL = RK_SLOT(DIR == 0 ? 3 : 17); LAS unsigned char* sAL0 = RK_SLOT(3);
    LAS float* PS = (LAS float*)(RK_SLOT(0) + 5120); LAS float* GC = (LAS float*)(RK_SLOT(0) + 4608);
    float ld[8], av[8];
    float psum = 0.f;
#pragma unroll
    for (int e = 0; e < 8; ++e) {
        const float wl = bf2f(*(const LAS bf16*)(sWL + toff(tl0 + e, lane))), al = bf2f(*(const LAS bf16*)(sAL + toff(tl0 + e, lane)));
        ld[e] = -EM05 * sigmoidf_(wl); av[e] = sigmoidf_(al); psum += ld[e];
        if (DIR == 1 && lat) {
            const float a0 = sigmoidf_(bf2f(*(const LAS bf16*)(sAL0 + toff(tl0 + e, lane))));
            const float bs = wave_sum(rv[e] * kv[e] * (2.0f + (a0 + av[e] - 2.0f) * K_kac) * K_rkc);
            BVg[(tl0 + e) * 64 + lane] = (bf16)f2bf(bs * vv[e]); }
    }
    PS[g * 64 + lane] = psum;
    RK_BAR();
    float carry = 0.f, total = 0.f;
#pragma unroll
    for (int gg = 0; gg < 8; ++gg) { const float s = PS[gg * 64 + lane]; total += s; if (DIR == 0 ? (gg < g) : (gg > g)) carry += s; }
    if (g == 0) GC[lane] = fast_exp(total);
    float lam = carry;
    unsigned atT[4], bhT[4], khT[4], vT[4];
    float h_at = 0.f, h_bh = 0.f, h_kh = 0.f, h_v = 0.f;
#pragma unroll
    for (int s = 0; s < 8; ++s) {
        const int e = DIR == 0 ? s : 7 - s;
        const int ip = DIR == 0 ? tl0 + e : 63 - (tl0 + e);
        lam += ld[e];
        const float G_ = fast_exp(lam), Gp = fast_exp(lam - ld[e]), iG = fast_exp(-lam), GCG = fast_exp(total - lam);
        const float kd = kv[e] * (1.0f + (av[e] - 1.0f) * K_kac), be = kk[e] * av[e];
        const float at = -kk[e] * Gp, rt = rv[e] * G_, bt = be * iG, kt = kd * iG, bh = be * GCG, kh = kd * GCG;
        *(LAS bf16*)(RK_SLOT(4) + toff(ip, lane)) = (bf16)f2bf(at); *(LAS bf16*)(RK_SLOT(6) + toff(ip, lane)) = (bf16)f2bf(rt);
        *(LAS bf16*)(RK_SLOT(7) + toff(ip, lane)) = (bf16)f2bf(bt); *(LAS bf16*)(RK_SLOT(8) + toff(ip, lane)) = (bf16)f2bf(kt);
        if (s & 1) { atT[s >> 1] = pkbf(h_at, at); bhT[s >> 1] = pkbf(h_bh, bh); khT[s >> 1] = pkbf(h_kh, kh); vT[s >> 1] = pkbf(h_v, vv[e]); }
        else { h_at = at; h_bh = bh; h_kh = kh; h_v = vv[e]; }
    }
    const int ip0 = DIR == 0 ? tl0 : 56 - tl0;
    *(LAS v4u*)(RK_SLOT(5) + toff(lane, ip0)) = (v4u){atT[0], atT[1], atT[2], atT[3]};
    *(LAS v4u*)(RK_SLOT(9) + toff(lane, ip0)) = (v4u){bhT[0], bhT[1], bhT[2], bhT[3]};
    *(LAS v4u*)(RK_SLOT(10) + toff(lane, ip0)) = (v4u){khT[0], khT[1], khT[2], khT[3]};
    *(LAS v4u*)(RK_SLOT(11) + toff(lane, ip0)) = (v4u){vT[0], vT[1], vT[2], vT[3]};
}

__device__ __forceinline__ void r1_unit(KP A, LAS unsigned char* lds, const R1Const& K, const Raw& R, int b, int h, int chunk, int tid, int lane, int wave) {
    unsigned char* ws = A->ws;
    const bf16* RW = (const bf16*)(ws + WS_RW);
    const bool lat = chunk >= 4; const int lc = chunk - 4;
    size_t rowbase; int t0, seqlen; r1_unit_geom(b, chunk, rowbase, t0, seqlen);
    bf16* OUT = lat ? (bf16*)(ws + WS_R1L) + ((size_t)(b * 8 + h) * 64 + lc) * (8 * 4096) : (bf16*)(ws + WS_R1C) + ((size_t)(b * 8 + h) * 4 + chunk) * (4 * 4096);
    const int qt = wave & 3, pt0 = 2 * (wave >> 2);
    const float* cw = A->in[I_CONVW];
    const int lane_in = lane;
    bf16x8 wf[4][2];
    { const int ln = opq(lane_in); const bf16* WL = (const bf16*)(ws + WS_WLORA) + (size_t)h * (4 * 64 * 32) + (16 * pt0 + (ln & 15)) * 32 + 8 * (ln >> 4);
#pragma unroll
      for (int m = 0; m < 4; ++m)
#pragma unroll
          for (int i = 0; i < 2; ++i) wf[m][i] = *(const bf16x8*)(WL + m * (64 * 32) + i * (16 * 32)); }
    float rv[8], kv[8], vv[8], kk[8];
    { const int lane = opq(lane_in); const int tl0 = 8 * wave, col = 1536 + lane; const float c0 = cw[col], c1 = cw[RWW + col], c2 = cw[2 * RWW + col];
      const int cga = opq(K.cg); const float K_kkc = K.kk_p[cga];
      const float K_cr0 = cw[cga], K_cr1 = cw[RWW + cga], K_cr2 = cw[2 * RWW + cga], K_ck0 = cw[512 + cga], K_ck1 = cw[RWW + 512 + cga], K_ck2 = cw[2 * RWW + 512 + cga], K_cv0 = cw[1024 + cga], K_cv1 = cw[RWW + 1024 + cga], K_cv2 = cw[2 * RWW + 1024 + cga];
#pragma unroll
      for (int e = 0; e < 8; ++e) {
          rv[e] = K_cr0 * RK_RAW(R.pr, e) + K_cr1 * RK_RAW(R.pr, e + 1) + K_cr2 * RK_RAW(R.pr, e + 2); kv[e] = K_ck0 * RK_RAW(R.pk, e) + K_ck1 * RK_RAW(R.pk, e + 1) + K_ck2 * RK_RAW(R.pk, e + 2); vv[e] = K_cv0 * RK_RAW(R.pv, e) + K_cv1 * RK_RAW(R.pv, e + 1) + K_cv2 * RK_RAW(R.pv, e + 2);
          const float kkr = kv[e] * K_kkc; const float ss = wave_sum(kkr * kkr); kk[e] = kkr * __builtin_amdgcn_rsqf(fmaxf(ss, 1e-24f));
          const float v = c0 * RK_RAW(R.ph, e) + c1 * RK_RAW(R.ph, e + 1) + c2 * RK_RAW(R.ph, e + 2);
          const float o = lane < 32 ? 1.0f - 2.0f * fast_rcp(1.0f + fast_exp(2.0f * v)) : v;
          *(LAS bf16*)(RK_SLOT(0) + toff(tl0 + e, lane)) = (bf16)f2bf(o); }
    }
    RK_BAR();
    { const int lane = opq(lane_in); const int c = lane & 15, qd = lane >> 4;
      const bf16x8 yth = ldfrag(RK_SLOT(0), 16 * qt + c, 8 * qd), yha = ldfrag(RK_SLOT(0), 16 * qt + c, 32 + 8 * qd);
#pragma unroll
      for (int dd = 0; dd < 2; ++dd)
#pragma unroll
          for (int i = 0; i < 2; ++i) { const int p0 = 16 * (pt0 + i) + 4 * qd, q = 16 * qt + c;
              const f32x4 bw = *(const f32x4*)(A->in[I_DW0] + dd * 512 + h * 64 + p0), ba = *(const f32x4*)(A->in[I_IA0] + dd * 512 + h * 64 + p0);
              const f32x4 dw = RK_MFMA(wf[dd][i], yth, bw), da = RK_MFMA(wf[2 + dd][i], yha, ba);
              st_nat(RK_SLOT(dd == 0 ? 1 : 16), q, p0, dw); st_nat(RK_SLOT(dd == 0 ? 3 : 17), q, p0, da); } }
    RK_BAR();
#pragma unroll 1
    for (int d = 0; d < 2; ++d) {
        bf16* BVg = OUT + 7 * 4096;
        if (d == 0) r1_elem<0>(lds, K, rv, kv, vv, kk, lat, BVg, lane_in, wave); else r1_elem<1>(lds, K, rv, kv, vv, kk, lat, BVg, lane_in, wave);
        RK_BAR();
        const int lane = opq(lane_in); const int c = lane & 15, qd = lane >> 4;
        { LAS float* LD = (LAS float*)RK_SLOT(0);
          mm64(RK_SLOT(4), RK_SLOT(7), wave, lane, [&](int pt, int qtt, f32x4 dd, int p0, int q) {
              if (pt == qtt) {
#pragma unroll
                  for (int r = 0; r < 4; ++r) LD[(pt * 16 + 4 * qd + r) * 17 + c] = (q < p0 + r) ? dd[r] : 0.f;
                  st_nat(RK_SLOT(12), q, p0, (f32x4){0.f, 0.f, 0.f, 0.f});
              } else st_nat(RK_SLOT(12), q, p0, pt > qtt ? dd : (f32x4){0.f, 0.f, 0.f, 0.f}); });
          mm64(RK_SLOT(8), RK_SLOT(4), wave, lane, [&](int, int, f32x4 dd, int p0, int q) {
#pragma unroll
              for (int r = 0; r < 4; ++r) dd[r] = (p0 + r < q) ? dd[r] : 0.f;
              st_nat(RK_SLOT(13), q, p0, dd); });
          mm64(RK_SLOT(7), RK_SLOT(6), wave, lane, [&](int, int, f32x4 dd, int p0, int q) {
#pragma unroll
              for (int r = 0; r < 4; ++r) dd[r] = (p0 + r <= q) ? dd[r] : 0.f;
              st_nat(RK_SLOT(14), q, p0, dd); });
          mm64(RK_SLOT(8), RK_SLOT(6), wave, lane, [&](int, int, f32x4 dd, int p0, int q) {
#pragma unroll
              for (int r = 0; r < 4; ++r) dd[r] = (p0 + r <= q) ? dd[r] : 0.f;
              st_nat(RK_SLOT(15), q, p0, dd); }); }
        RK_BAR();
        mm64(RK_SLOT(13), RK_SLOT(11), wave, lane, [&](int, int, f32x4 dd, int p0, int q) { st_nat(RK_SLOT(4), q, p0, dd); });
        { const int zr = tid >> 3, zc = (tid & 7) ^ (zr & 7);
          if ((zc >> 1) != (zr >> 4)) { ((LAS v4u*)RK_SLOT(7))[tid] = (v4u){0u, 0u, 0u, 0u}; ((LAS v4u*)RK_SLOT(8))[tid] = (v4u){0u, 0u, 0u, 0u}; } }
        if (wave == 0) { const LAS float* LD = (const LAS float*)RK_SLOT(0); const int blk = lane >> 4, col = lane & 15;
            float pacc[16];
#pragma unroll
            for (int t = 0; t < 16; ++t) pacc[t] = (t == col) ? 1.0f : 0.0f;
#pragma unroll
            for (int r = 0; r < 15; ++r) {
#pragma unroll
                for (int t = r + 1; t < 16; ++t) pacc[t] += LD[(blk * 16 + t) * 17 + r] * pacc[r]; }
#pragma unroll
            for (int r = 0; r < 16; ++r) *(LAS bf16*)(RK_SLOT(7) + toff(blk * 16 + r, blk * 16 + col)) = (bf16)f2bf(pacc[r]);
            *(LAS v4u*)(RK_SLOT(8) + toff(blk * 16 + col, blk * 16)) = (v4u){pkbf(pacc[0], pacc[1]), pkbf(pacc[2], pacc[3]), pkbf(pacc[4], pacc[5]), pkbf(pacc[6], pacc[7])};
            *(LAS v4u*)(RK_SLOT(8) + toff(blk * 16 + col, blk * 16 + 8)) = (v4u){pkbf(pacc[8], pacc[9]), pkbf(pacc[10], pacc[11]), pkbf(pacc[12], pacc[13]), pkbf(pacc[14], pacc[15])}; }
        RK_BAR();
        mm64(RK_SLOT(7), RK_SLOT(12), wave, lane, [&](int, int, f32x4 dd, int p0, int q) { st_tr(RK_SLOT(1), p0, q, dd); st_nat(RK_SLOT(2), q, p0, dd); });
        RK_BAR();
        mm64(RK_SLOT(1), RK_SLOT(2), wave, lane, [&](int, int, f32x4 dd, int p0, int q) {
#pragma unroll
            for (int r = 0; r < 4; ++r) dd[r] += (p0 + r == q) ? 1.0f : 0.0f;
            st_nat(RK_SLOT(12), q, p0, dd); });
        RK_BAR();
        mm64(RK_SLOT(1), RK_SLOT(12), wave, lane, [&](int, int, f32x4 dd, int p0, int q) {
            const v2u w = *(const LAS v2u*)(RK_SLOT(12) + toff(q, p0));
            dd[0] += bf_lo(w.x); dd[1] += bf_hi(w.x); dd[2] += bf_lo(w.y); dd[3] += bf_hi(w.y);
            st_tr(RK_SLOT(13), p0, q, dd); });
        RK_BAR();
        mm64(RK_SLOT(13), RK_SLOT(8), wave, lane, [&](int, int, f32x4 dd, int p0, int q) { st_tr(RK_SLOT(2), p0, q, dd); });
        RK_BAR();
        mm64(RK_SLOT(2), RK_SLOT(5), wave, lane, [&](int, int, f32x4 dd, int p0, int q) { st_nat(RK_SLOT(7), q, p0, dd); });
        mm64(RK_SLOT(2), RK_SLOT(4), wave, lane, [&](int, int, f32x4 dd, int p0, int q) { st_nat(RK_SLOT(1), q, p0, dd); });
        RK_BAR();
        { bf16* Gg = OUT + (2 * d) * 4096; bf16* HTg = OUT + (2 * d + 1) * 4096;
          const LAS float* GC = (const LAS float*)(RK_SLOT(0) + 4608);
          mm64(RK_SLOT(7), RK_SLOT(9), wave, lane, [&](int, int, f32x4 dd, int p0, int q) {
#pragma unroll
              for (int r = 0; r < 4; ++r) dd[r] += (p0 + r == q) ? GC[q] : 0.0f;
              st_gnat(Gg, q, p0, dd); });
          mm64_2(RK_SLOT(9), RK_SLOT(1), RK_SLOT(10), RK_SLOT(11), wave, lane, [&](int, int, f32x4 dd, int p0, int q) { st_gnat(HTg, q, p0, dd); });
          if (lat) { bf16* YSg = OUT + (4 + d) * 4096; bf16* Y0g = OUT + 6 * 4096;
              mm64(RK_SLOT(7), RK_SLOT(14), wave, lane, [&](int, int, f32x4 dd, int p0, int q) {
                  const v2u w = *(const LAS v2u*)(RK_SLOT(6) + toff(q, p0));
                  dd[0] += bf_lo(w.x); dd[1] += bf_hi(w.x); dd[2] += bf_lo(w.y); dd[3] += bf_hi(w.y);
                  st_gnat(YSg, q, p0, dd); });
              mm64_2(RK_SLOT(1), RK_SLOT(14), RK_SLOT(11), RK_SLOT(15), wave, lane, [&](int, int, f32x4 dd, int p0, int q) {
                  if (d == 0) st_nat(RK_SLOT(18), q, p0, dd);
                  else { const v2u w = *(const LAS v2u*)(RK_SLOT(18) + toff(63 - q, p0));
                      dd[0] += bf_lo(w.x); dd[1] += bf_hi(w.x); dd[2] += bf_lo(w.y); dd[3] += bf_hi(w.y);
                      st_gnat(Y0g, 63 - q, p0, dd); } }); } }
        RK_BAR();
    }
}

__device__ __forceinline__ void phase_r1(KP A, LAS unsigned char* lds, int vcu, int G, int tid, int lane, int wave) {
    const int h = (vcu >> 5) & 7;
    R1Const K; K.kk_p = A->in[I_KK]; K.ka_p = A->in[I_KA]; K.rk_p = A->in[I_RK]; K.cw = A->in[I_CONVW]; K.cg = h * 64 + lane;
    if (G != 256) return;
    const bf16* RW = (const bf16*)(A->ws + WS_RW);
#pragma unroll 1
    for (int i = 0; i < 9; ++i) { const int idx = i * 32 + (vcu & 31); if (idx >= 272) break;
        Raw cur; r1_load_raw(cur, RW, idx / 68, h, idx % 68, lane, wave);
        r1_unit(A, lds, K, cur, idx / 68, h, idx % 68, tid, lane, wave); }
}

__device__ __forceinline__ void phase_r2(KP A, LAS unsigned char* lds, int vcu, int G, int tid, int lane, int wave) {
    unsigned char* ws = A->ws;
    constexpr int SLOT = 8192 + 2304, BATCH = 4;
    for (int unit = vcu; unit < 256; unit += G) {
        const int b = unit >> 6, h = (unit >> 3) & 7, dir = (unit >> 2) & 1, vq = unit & 3;
        const int c = lane & 15, qd = lane >> 4;
        LAS unsigned char* ZT = lds + 2 * BATCH * SLOT;
        bf16x8 zy0 = (bf16x8){0, 0, 0, 0, 0, 0, 0, 0}, zy1 = zy0;
#define R2_SRC(step, Gp, Hp, cid) do { cid = dir == 0 ? (step) : ((step) < 4 ? 3 - (step) : 71 - (step)); \
            const bf16* base_ = cid < 4 ? (const bf16*)(ws + WS_R1C) + ((size_t)(b * 8 + h) * 4 + cid) * (4 * 4096) : (const bf16*)(ws + WS_R1L) + ((size_t)(b * 8 + h) * 64 + (cid - 4)) * (8 * 4096); \
            Gp = base_ + (2 * dir) * 4096; Hp = base_ + (2 * dir + 1) * 4096; } while (0)
#define R2_STAGE(nb) do { const int step_ = (nb) * BATCH + (wave - 1); if (step_ < 68) { const bf16* Gp; const bf16* Hp; int cid_; R2_SRC(step_, Gp, Hp, cid_); (void)cid_; \
            LAS unsigned char* dst = lds + (((nb) & 1) * BATCH + (wave - 1)) * SLOT; \
            _Pragma("unroll") for (int i = 0; i < 8; ++i) { const int idx = i * 64 + lane, row = idx >> 3, ch = idx & 7; const v4u v = *(const v4u*)(Gp + row * 64 + ch * 8); *(LAS v4u*)(dst + rk::toff(row, ch * 8)) = v; } \
            _Pragma("unroll") for (int i = 0; i < 2; ++i) { const int idx = i * 64 + lane, row = idx >> 3, ch = idx & 7; const v4u v = *(const v4u*)(Hp + (16 * vq + row) * 64 + ch * 8); *(LAS v4u*)(dst + 8192 + row * 144 + ch * 16) = v; } } } while (0)
        if (wave >= 1 && wave <= BATCH) R2_STAGE(0);
        __syncthreads();
        for (int nb = 0; nb < 17; ++nb) {
            if (wave >= 1 && wave <= BATCH) { if (nb + 1 < 17) R2_STAGE(nb + 1); }
            else if (wave == 0) {
                for (int s = 0; s < BATCH; ++s) { const int step = nb * BATCH + s; if (step >= 68) break;
                    const bf16* Gp; const bf16* Hp; int cid; R2_SRC(step, Gp, Hp, cid); (void)Gp; (void)Hp;
                    const LAS unsigned char* src = lds + ((nb & 1) * BATCH + s) * SLOT;
                    if (cid >= 4) { bf16* Z0 = (bf16*)(ws + WS_Z0) + ((size_t)((b * 8 + h) * 2 + dir) * 64 + (cid - 4)) * 4096 + (16 * vq + c) * 64 + 8 * qd;
                        *(bf16x8*)Z0 = zy0; *(bf16x8*)(Z0 + 32) = zy1; }
                    f32x4 acc[4];
#pragma unroll
                    for (int pt = 0; pt < 4; ++pt) { const v2u hv = *(const LAS v2u*)(src + 8192 + c * 144 + (16 * pt + 4 * qd) * 2);
                        acc[pt] = (f32x4){bf_lo(hv.x), bf_hi(hv.x), bf_lo(hv.y), bf_hi(hv.y)};
                        acc[pt] = RK_MFMA(rk::ldfrag(src, 16 * pt + c, 8 * qd), zy0, acc[pt]);
                        acc[pt] = RK_MFMA(rk::ldfrag(src, 16 * pt + c, 32 + 8 * qd), zy1, acc[pt]); }
#pragma unroll
                    for (int pt = 0; pt < 4; ++pt) { v2u w; w.x = rk::pkbf(acc[pt][0], acc[pt][1]); w.y = rk::pkbf(acc[pt][2], acc[pt][3]); *(LAS v2u*)(ZT + c * 144 + (16 * pt + 4 * qd) * 2) = w; }
                    zy0 = *(const LAS bf16x8*)(ZT + c * 144 + (8 * qd) * 2); zy1 = *(const LAS bf16x8*)(ZT + c * 144 + (32 + 8 * qd) * 2);
                }
            }
            __syncthreads();
        }
#undef R2_STAGE
#undef R2_SRC
    }
}

__device__ __forceinline__ void phase_r3(KP A, LAS unsigned char* lds, int vcu, int G, int tid, int lane, int wave) {
    unsigned char* ws = A->ws;
    const int h = (vcu >> 5) & 7, c = lane & 15, qd = lane >> 4, tt = wave & 3, vh = wave >> 2;
    bf16x8 gf[2][3];
#pragma unroll
    for (int i = 0; i < 2; ++i)
#pragma unroll
        for (int s = 0; s < 3; ++s) { const float* src = A->in[I_GG2] + h * 64 + 32 * vh + 16 * i + c; float t[8];
#pragma unroll
            for (int j = 0; j < 8; ++j) t[j] = src[(size_t)(32 * s + 8 * qd + j) * 512];
            v4u w = {pkbf(t[0], t[1]), pkbf(t[2], t[3]), pkbf(t[4], t[5]), pkbf(t[6], t[7])}; gf[i][s] = __builtin_bit_cast(bf16x8, w); }
    f32x4 lw[2], lb[2];
#pragma unroll
    for (int i = 0; i < 2; ++i) { lw[i] = *(const f32x4*)(A->in[I_LNXW] + h * 64 + 32 * vh + 16 * i + 4 * qd); lb[i] = *(const f32x4*)(A->in[I_LNXB] + h * 64 + 32 * vh + 16 * i + 4 * qd); }
    LAS float* XS = (LAS float*)lds;
    if (G != 256) return;
    for (int it = 0; it < 8; ++it) { const int idx = it * 32 + (vcu & 31), b = idx >> 6, lc = idx & 63;
        const bf16* T8 = (const bf16*)(ws + WS_R1L) + ((size_t)(b * 8 + h) * 64 + lc) * (8 * 4096);
        const int tok = 16 * tt + c; const size_t row = (size_t)b * 4096 + (size_t)lc * 64 + tok;
        f32x4 acc[2];
#pragma unroll
        for (int i = 0; i < 2; ++i) { const v2u w = *(const v2u*)(T8 + 6 * 4096 + tok * 64 + 32 * vh + 16 * i + 4 * qd); acc[i] = (f32x4){bf_lo(w.x), bf_hi(w.x), bf_lo(w.y), bf_hi(w.y)}; }
#pragma unroll
        for (int d = 0; d < 2; ++d) { const bf16* Z0 = (const bf16*)(ws + WS_Z0) + ((size_t)((b * 8 + h) * 2 + d) * 64 + lc) * 4096;
            const bf16* YS = T8 + (4 + d) * 4096 + (d == 0 ? tok : 63 - tok) * 64;
            const bf16x8 y0 = *(const bf16x8*)(YS + 8 * qd), y1 = *(const bf16x8*)(YS + 32 + 8 * qd);
#pragma unroll
            for (int i = 0; i < 2; ++i) { const bf16* zr = Z0 + (32 * vh + 16 * i + c) * 64;
                acc[i] = RK_MFMA(*(const bf16x8*)(zr + 8 * qd), y0, acc[i]); acc[i] = RK_MFMA(*(const bf16x8*)(zr + 32 + 8 * qd), y1, acc[i]); } }
        float s1 = 0.f, s2 = 0.f;
#pragma unroll
        for (int i = 0; i < 2; ++i)
#pragma unroll
            for (int r = 0; r < 4; ++r) { s1 += acc[i][r]; s2 += acc[i][r] * acc[i][r]; }
        s1 += __shfl_xor(s1, 16); s1 += __shfl_xor(s1, 32); s2 += __shfl_xor(s2, 16); s2 += __shfl_xor(s2, 32);
        if (qd == 0) { XS[(vh * 64 + tok) * 2] = s1; XS[(vh * 64 + tok) * 2 + 1] = s2; }
        __syncthreads();
        const float t1 = XS[tok * 2] + XS[(64 + tok) * 2], t2 = XS[tok * 2 + 1] + XS[(64 + tok) * 2 + 1];
        const float mu = t1 * (1.f / 64.f), var = fmaxf(t2 * (1.f / 64.f) - mu * mu, 0.f), rstd = __builtin_amdgcn_rsqf(var + LNX_EPS);
        const bf16* hg = (const bf16*)(ws + WS_HGS) + row * 96;
        f32x4 gacc[2] = {(f32x4){0.f, 0.f, 0.f, 0.f}, (f32x4){0.f, 0.f, 0.f, 0.f}};
#pragma unroll
        for (int s = 0; s < 3; ++s) { const bf16x8 yh = *(const bf16x8*)(hg + 32 * s + 8 * qd);
#pragma unroll
            for (int i = 0; i < 2; ++i) gacc[i] = RK_MFMA(gf[i][s], yh, gacc[i]); }
        bf16* YRW = (bf16*)(ws + WS_YRW) + row * 512 + h * 64;
#pragma unroll
        for (int i = 0; i < 2; ++i) { const int v0 = 32 * vh + 16 * i + 4 * qd;
            const v2u bw = *(const v2u*)(T8 + 7 * 4096 + tok * 64 + v0);
            const float bv[4] = {bf_lo(bw.x), bf_hi(bw.x), bf_lo(bw.y), bf_hi(bw.y)};
            f32x4 o;
#pragma unroll
            for (int r = 0; r < 4; ++r) o[r] = ((acc[i][r] - mu) * rstd * lw[i][r] + lb[i][r] + bv[r]) * gacc[i][r];
            v2u w; w.x = pkbf(o[0], o[1]); w.y = pkbf(o[2], o[3]); *(v2u*)(YRW + v0) = w; }
        __syncthreads();
    }
}
#undef RK_SLOT
#undef RK_MFMA
}
__device__ __forceinline__ int win_col(int n) {
    if (n < 640) { const int base = n & ~63, p = n & 63; return base + (p >> 1) + 32 * (p & 1); }
    if (n < 768) return n;
    if (n < 2560) { const int j = n - 768; return j < RWW ? 768 + j : -1; }
    return 2464 + (n - 2560);
}
template <bool MAPPED> __device__ __forceinline__ void transpose_item(const float* W, int K, int N, bf16* WT, LAS float* scr, int item, int nblk, int lane) {
    const int kb = item / nblk, nb = item % nblk, k0 = 64 * kb, n0 = 32 * nb;
    const int oc = MAPPED ? win_col(n0 + (lane & 31)) : (n0 + (lane & 31));
#pragma unroll 8
    for (int i = 0; i < 32; ++i) { const int kk = 2 * i + (lane >> 5); scr[kk * 33 + (lane & 31)] = oc >= 0 ? W[(size_t)(k0 + kk) * N + oc] : 0.f; }
    LDS_WAIT(); asm volatile("" ::: "memory");
    const int c = lane & 7;
#pragma unroll
    for (int j = 0; j < 4; ++j) { const int n = (lane >> 3) + 8 * j; const LAS float* s = scr + (8 * c) * 33 + n;
        v4u o; o.x = pk2(s[0 * 33], s[1 * 33]); o.y = pk2(s[2 * 33], s[3 * 33]); o.z = pk2(s[4 * 33], s[5 * 33]); o.w = pk2(s[6 * 33], s[7 * 33]);
        *(GAS v4u*)(WT + (size_t)(n0 + n) * K + k0 + 8 * c) = o; }
    LDS_WAIT(); asm volatile("" ::: "memory");
}

__device__ __forceinline__ void sincos_f(float ang, float& s, float& c) {
    const float k = rintf(ang * 0.63661977236758134f);
    float r = fmaf(-k, 1.5707963705062866f, ang); r = fmaf(-k, -4.371139006309477e-08f, r);
    const float r2 = r * r;
    const float sp = r + r * r2 * (-1.6666667e-1f + r2 * (8.3333333e-3f + r2 * (-1.9841270e-4f + r2 * 2.7557319e-6f)));
    const float cp = 1.0f + r2 * (-0.5f + r2 * (4.1666667e-2f + r2 * (-1.3888889e-3f + r2 * (2.4801587e-5f + r2 * -2.7557319e-7f))));
    const int q = ((int)k) & 3;
    s = (q == 0) ? sp : (q == 1) ? cp : (q == 2) ? -sp : -cp;
    c = (q == 0) ? cp : (q == 1) ? -sp : (q == 2) ? -cp : sp;
}

__device__ __forceinline__ void phase0(KP A, LAS unsigned char* lds, int vcu, int G, int tid, int lane, int wave) {
    unsigned char* ws = A->ws;
    { LAS float* scr = (LAS float*)(lds + wave * 16384);
      const int gw = vcu * 8 + wave, NGW = G * 8;
      constexpr int I_IN = 16 * (NIN / 32), I_A = 8 * 32, I_O = 16 * 32, I_U = 16 * 128, I_D = 64 * 32;
      constexpr int NITEMS = I_IN + 2 * I_A + I_O + I_U + I_D;
      for (int it = gw; it < NITEMS; it += NGW) {
          int r = it;
          if (r < I_IN) { transpose_item<true>(A->in[I_WIN], 1024, 4512, (bf16*)(ws + WS_WIN), scr, r, NIN / 32, lane); continue; } r -= I_IN;
          if (r < I_A) { transpose_item<false>(A->in[I_WBA], 512, 1024, (bf16*)(ws + WS_WA), scr, r, 32, lane); continue; } r -= I_A;
          if (r < I_A) { transpose_item<false>(A->in[I_WBR], 512, 1024, (bf16*)(ws + WS_WR), scr, r, 32, lane); continue; } r -= I_A;
          if (r < I_O) { transpose_item<false>(A->in[I_WOUT], 1024, 1024, (bf16*)(ws + WS_WO), scr, r, 32, lane); continue; } r -= I_O;
          if (r < I_U) { transpose_item<false>(A->in[I_WUP], 1024, 4096, (bf16*)(ws + WS_WU), scr, r, 128, lane); continue; } r -= I_U;
          transpose_item<false>(A->in[I_WDN], 4096, 1024, (bf16*)(ws + WS_WD), scr, r, 32, lane);
      } }
    { float* COS = (float*)(ws + WS_ROPE); float* SIN = COS + 4096 * 32;
      const float invf[16] = {1.0f, 0.5623413324356079f, 0.3162277638912201f, 0.17782793939113617f, 0.10000000149011612f, 0.05623413249850273f, 0.03162277489900589f, 0.017782794311642647f,
                              0.009999999776482582f, 0.005623413249850273f, 0.003162277629598975f, 0.0017782794311642647f, 0.0010000000474974513f, 0.000562341301701963f, 0.0003162277571391314f, 0.00017782794020604342f};
      for (int e = vcu * 512 + tid; e < 4096 * 32; e += G * 512) {
          const int pos = e >> 5, i = e & 31; float f = invf[0];
#pragma unroll
          for (int q = 1; q < 16; ++q) f = ((i & 15) == q) ? invf[q] : f;
          const float ang = (float)(i < 16 ? (pos >> 6) : (pos & 63)) * f;
          float s, c; sincos_f(ang, s, c); COS[e] = c; SIN[e] = s; } }
    { bf16* WL = (bf16*)(ws + WS_WLORA);
      for (int e = vcu * 512 + tid; e < 65536; e += G * 512) { const int hh = e >> 13, m = (e >> 11) & 3, ch = (e >> 5) & 63, j = e & 31;
          WL[e] = (bf16)f2bf((m < 2 ? A->in[I_DW2] : A->in[I_IA2])[(size_t)((m & 1) * 32 + j) * 512 + hh * 64 + ch]); } }
    __syncthreads();
    { LAS float* SC = (LAS float*)lds;
      LAS float* RED = (LAS float*)(lds + 32768);
      for (int e = tid; e < 5 * 1024; e += 512) { const int b = e >> 10, k = e & 1023; const float v = b < 4 ? A->in[I_C][b * 1024 + k] : A->in[I_CCTX][k]; SC[e] = v * sigmoidf_(v); }
      __syncthreads();
      float* MOD = (float*)(ws + WS_MOD);
      for (int slab = vcu; slab < 192; slab += G) {
          const int col = tid & 31, kg = tid >> 5, j0 = slab * 32;
          float a0 = 0.f, a1 = 0.f, a2 = 0.f, a3 = 0.f, a4 = 0.f;
          const float* wp = A->in[I_WADA] + (size_t)(kg * 64) * 6144 + j0 + col;
#pragma unroll 8
          for (int k = 0; k < 64; ++k) { const float w = wp[(size_t)k * 6144]; const int kk = kg * 64 + k;
              a0 += SC[kk] * w; a1 += SC[1024 + kk] * w; a2 += SC[2048 + kk] * w; a3 += SC[3072 + kk] * w; a4 += SC[4096 + kk] * w; }
          RED[(kg * 5 + 0) * 32 + col] = a0; RED[(kg * 5 + 1) * 32 + col] = a1; RED[(kg * 5 + 2) * 32 + col] = a2; RED[(kg * 5 + 3) * 32 + col] = a3; RED[(kg * 5 + 4) * 32 + col] = a4;
          __syncthreads();
          if (tid < 160) { const int b = tid >> 5, c = tid & 31; float s = A->in[I_BADA][j0 + c];
#pragma unroll
              for (int g = 0; g < 16; ++g) s += RED[(g * 5 + b) * 32 + c];
              MOD[b * 6144 + j0 + c] = s; }
          __syncthreads();
      } }
}

__device__ __forceinline__ void phase1(KP A, int vcu, int G, int lane, int wave) {
    unsigned char* ws = A->ws; const float* MOD = (const float*)(ws + WS_MOD);
    const int gw = vcu * 8 + wave, NGW = G * 8;
    bf16* HB = (bf16*)(ws + WS_HB);
    for (int m = gw; m < MT; m += NGW) {
        const float* xrow = m < ML ? A->in[I_X] + (size_t)m * DM : A->in[I_CTX] + (size_t)(m - ML) * DM;
        const float* mod = MOD + (m < ML ? (m >> 12) : 4) * 6144;
        const GAS f32x4* xr = (const GAS f32x4*)xrow + lane;
        f32x4 v[4]; float s = 0.f;
#pragma unroll
        for (int j = 0; j < 4; ++j) { v[j] = xr[64 * j]; s += (v[j].x * v[j].x + v[j].y * v[j].y) + (v[j].z * v[j].z + v[j].w * v[j].w); }
        const float rstd = __builtin_amdgcn_rsqf(wave_sum(s) * (1.f / DM) + NORM_EPS);
        GAS unsigned long long* o8 = (GAS unsigned long long*)(HB + (size_t)m * DM) + lane;
#pragma unroll
        for (int j = 0; j < 4; ++j) { const int c = 4 * lane + 256 * j;
            const f32x4 g = *(const f32x4*)(A->in[I_N1G] + c), sh = *(const f32x4*)(mod + c), sc = *(const f32x4*)(mod + 1024 + c);
            const f32x4 h = v[j] * rstd * g * (sc + 1.0f) + sh;
            o8[64 * j] = (unsigned long long)pk2(h.x, h.y) | ((unsigned long long)pk2(h.z, h.w) << 32); }
    }
    const bf16* WU = (const bf16*)(ws + WS_WU); float* CB = (float*)(ws + WS_CB);
    for (int n = gw; n < FF; n += NGW) {
        const v4u* wr = (const v4u*)(WU + (size_t)n * 1024) + 2 * lane;
        const v4u w0 = wr[0], w1 = wr[1];
        float wv[16] = {bf_lo(w0.x), bf_hi(w0.x), bf_lo(w0.y), bf_hi(w0.y), bf_lo(w0.z), bf_hi(w0.z), bf_lo(w0.w), bf_hi(w0.w),
                        bf_lo(w1.x), bf_hi(w1.x), bf_lo(w1.y), bf_hi(w1.y), bf_lo(w1.z), bf_hi(w1.z), bf_lo(w1.w), bf_hi(w1.w)};
#pragma unroll
        for (int b = 0; b < 4; ++b) { const float* sh = MOD + b * 6144 + 3 * 1024 + 16 * lane; float s = 0.f;
#pragma unroll
            for (int e = 0; e < 16; ++e) s += sh[e] * wv[e];
            s = wave_sum(s); if (lane == 0) CB[b * 4096 + n] = s; }
    }
}

__device__ __forceinline__ void phase_final(KP A, int vcu, int G, int lane, int wave) {
    const float* SS = (const float*)(A->ws + WS_SS2);
    const int gw = vcu * 8 + wave, NGW = G * 8;
    for (int m = gw; m < ML; m += NGW) {
        float s = 0.f;
#pragma unroll
        for (int p = 0; p < 16; ++p) s += SS[(size_t)p * 16384 + m];
        const float rstd = __builtin_amdgcn_rsqf(s * (1.f / DM) + NORM_EPS);
        GAS f32x4* xr = (GAS f32x4*)(A->out + (size_t)m * DM) + lane;
#pragma unroll
        for (int j = 0; j < 4; ++j) { const f32x4 g = *(const f32x4*)(A->in[I_NFG] + 4 * lane + 256 * j); xr[64 * j] = xr[64 * j] * rstd * g; }
    }
}

__global__ void __launch_bounds__(512, 2) fwd_kernel(Args args) {
    extern __shared__ __attribute__((aligned(16))) unsigned char lds_raw[];
    LAS unsigned char* lds = (LAS unsigned char*)lds_raw;
    volatile LAS unsigned* MISC = (volatile LAS unsigned*)(lds + MISC_OFF);
    const int tid = threadIdx.x, lane = tid & 63, wave = __builtin_amdgcn_readfirstlane(tid >> 6);
    const int G = gridDim.x; const int bx = blockIdx.x; const int vcu = (G % 8 == 0) ? (bx % 8) * (G / 8) + bx / 8 : bx;
    KP ap = kargs_opaque(); unsigned char* ws = ap->ws;
    gu32* ctl = (gu32*)(ws + WS_CTL);
    for (int u = tid; u < (LDS_BYTES - LDSCTL_OFF) / 4; u += 512) ((LAS unsigned*)(lds + LDSCTL_OFF))[u] = 0u;
    __syncthreads();
    XcdBarrier bar; bar.bar = (unsigned*)(ctl + CW_BAR); bar.x = 0; bar.st = nullptr;
    if (N_LAUNCHES == 1) bar = xcd_barrier_post((unsigned*)(ctl + CW_BAR), MISC + 8);
    const int lo = ap->ph_lo, hi = ap->ph_hi;

#ifndef PHMASK
#define PHMASK 0xFFFu
#endif
#define IN(k) ((((PHMASK) >> (k)) & 1u) && lo <= (k) && (k) < hi)
#define SEAM(k) do { if (IN(k) && IN((k) + 1)) xcd_barrier(bar); } while (0)


#ifndef PROBE_DOUBLE
#define PROBE_DOUBLE 0u
#endif
#define NREP(k) ((((PROBE_DOUBLE) >> (k)) & 1u) ? opaque_i(2) : 1)
#ifndef PROBE_T_PHASE
#define PROBE_T_PHASE (-1)
#endif
#ifndef PROBE_T_Q
#define PROBE_T_Q 50
#endif
#define TSTAMP(k) do { if (PROBE_T_PHASE >= 0 && bx == 0 && tid == 0 && ((k) == PROBE_T_PHASE || (k) == PROBE_T_PHASE + 1)) { const unsigned long long t_ = __builtin_amdgcn_s_memrealtime(); \
        MISC[16 + 2 * ((k) - PROBE_T_PHASE)] = (unsigned)t_; MISC[17 + 2 * ((k) - PROBE_T_PHASE)] = (unsigned)(t_ >> 32); } } while (0)
    TSTAMP(0);
    if (IN(0)) { for (int rep_ = 0; rep_ < NREP(0); ++rep_) { ap = kargs_opaque(); ws = ap->ws; phase0(ap, lds, vcu, G, tid, lane, wave); __syncthreads(); } SEAM(0); }
    TSTAMP(1);
    if (IN(1)) { for (int rep_ = 0; rep_ < NREP(1); ++rep_) { ap = kargs_opaque(); ws = ap->ws; phase1(ap, vcu, G, lane, wave); } SEAM(1); }
    TSTAMP(2);
    if (IN(2)) { for (int rep_ = 0; rep_ < NREP(2); ++rep_) { ap = kargs_opaque(); ws = ap->ws;
        pg8::Gemm g{(const pg8::bf16_t*)(ws + WS_HB), (const pg8::bf16_t*)(ws + WS_WIN), MT, NIN, DM};
        pg8::OrderX S; S.init(ML, NIN, G, bx, 32, 64, 4, 2);
        pg8::EpiInProj E{(bf16*)(ws + WS_Q), (bf16*)(ws + WS_K), (bf16*)(ws + WS_V), (bf16*)(ws + WS_RW), (bf16*)ap->out, (const float*)(ws + WS_ROPE), (const float*)(ws + WS_ROPE) + 4096 * 32, QSCALE};
        pg8::gemm_phase<pg8::EpiInProj, pg8::OrderX, true, true>(lds, g, S, E);
        }
        SEAM(2);
    }
    TSTAMP(3);
    if (IN(3)) { for (int rep_ = 0; rep_ < NREP(3); ++rep_) { ap = kargs_opaque(); ws = ap->ws;
        for (int u = vcu; u < 512; u += G) { const int b = u >> 7, g = (u >> 6) & 1, qb = u & 63;
            att::attn_unit(b, g, qb, (const bf16*)(ws + WS_Q), (const bf16*)(ws + WS_K), (const bf16*)(ws + WS_V), (bf16*)(ws + WS_YA), ap->in[I_SINK], lds); }
        {
          const bf16* RWb = (const bf16*)(ws + WS_RW); bf16* HGS = (bf16*)(ws + WS_HGS); const float* cw = ap->in[I_CONVW];
          for (int e = vcu * 512 + tid; e < ML * 12; e += G * 512) { const int row = e / 12, c8 = (e % 12) * 8, t = row & 4095;
              const v4u x0 = *(const v4u*)(RWb + (size_t)row * RWP + 1600 + c8);
              const v4u xm = t > 0 ? *(const v4u*)(RWb + (size_t)(row - 1) * RWP + 1600 + c8) : (v4u){0u, 0u, 0u, 0u};
              const v4u xp = t < 4095 ? *(const v4u*)(RWb + (size_t)(row + 1) * RWP + 1600 + c8) : (v4u){0u, 0u, 0u, 0u};
              const unsigned m_[4] = {xm.x, xm.y, xm.z, xm.w}, z_[4] = {x0.x, x0.y, x0.z, x0.w}, p_[4] = {xp.x, xp.y, xp.z, xp.w}; unsigned o_[4];
#pragma unroll
              for (int q = 0; q < 4; ++q) { const int cl = 1600 + c8 + 2 * q;
                  const float lo = cw[cl] * bf_lo(m_[q]) + cw[RWW + cl] * bf_lo(z_[q]) + cw[2 * RWW + cl] * bf_lo(p_[q]);
                  const float hi = cw[cl + 1] * bf_hi(m_[q]) + cw[RWW + cl + 1] * bf_hi(z_[q]) + cw[2 * RWW + cl + 1] * bf_hi(p_[q]);
                  o_[q] = pk2(sigmoidf_(lo), sigmoidf_(hi)); }
              *(v4u*)(HGS + (size_t)row * 96 + c8) = (v4u){o_[0], o_[1], o_[2], o_[3]}; } }
        }
        SEAM(3);
    }
    TSTAMP(4);
    if (IN(4)) { ap = kargs_opaque(); ws = ap->ws;
        { pg8::Gemm g{(const pg8::bf16_t*)(ws + WS_YA), (const pg8::bf16_t*)(ws + WS_WA), ML, DM, 512};
          pg8::OrderX S; S.init(ML, DM, G, bx);
          pg8::EpiBranch<0> E{(bf16*)ap->out, nullptr};
          pg8::gemm_phase<pg8::EpiBranch<0>, pg8::OrderX, true, true>(lds, g, S, E); }
        __syncthreads();
        for (int rep_ = 0; rep_ < NREP(4); ++rep_) { ap = kargs_opaque(); rk::phase_r1(ap, lds, vcu, G, tid, lane, wave); }
        SEAM(4);
    }
    TSTAMP(5);
    if (IN(5)) { for (int rep_ = 0; rep_ < NREP(5); ++rep_) { ap = kargs_opaque(); ws = ap->ws; rk::phase_r2(ap, lds, vcu, G, tid, lane, wave); } SEAM(5); }
    TSTAMP(6);
    if (IN(6)) { for (int rep_ = 0; rep_ < NREP(6); ++rep_) { ap = kargs_opaque(); ws = ap->ws; rk::phase_r3(ap, lds, vcu, G, tid, lane, wave); } SEAM(6); }
    TSTAMP(7);
    if (IN(7)) { for (int rep_ = 0; rep_ < NREP(7); ++rep_) { ap = kargs_opaque(); ws = ap->ws;
        pg8::Gemm g{(const pg8::bf16_t*)(ws + WS_YRW), (const pg8::bf16_t*)(ws + WS_WR), ML, DM, 512};
        pg8::OrderX S; S.init(ML, DM, G, bx);
        pg8::EpiBranch<1> E{(bf16*)ap->out, (bf16*)(ws + WS_M1)};
        pg8::gemm_phase<pg8::EpiBranch<1>, pg8::OrderX, true, true>(lds, g, S, E);
        }
        SEAM(7);
    }
    TSTAMP(8);
    if (IN(8)) { for (int rep_ = 0; rep_ < NREP(8); ++rep_) { ap = kargs_opaque(); ws = ap->ws;
        pg8::Gemm g{(const pg8::bf16_t*)(ws + WS_M1), (const pg8::bf16_t*)(ws + WS_WO), ML, DM, DM};
        pg8::OrderX S; S.init(ML, DM, G, bx);
        pg8::EpiResid<0> E{ap->in[I_X], ap->out, (bf16*)(ws + WS_A2), (const float*)(ws + WS_MOD), ap->in[I_N2G], (float*)(ws + WS_SS1), 2 * 1024};
        pg8::gemm_phase<pg8::EpiResid<0>, pg8::OrderX, true, true>(lds, g, S, E);
        }
        SEAM(8);
    }
    TSTAMP(9);
    if (IN(9)) { for (int rep_ = 0; rep_ < NREP(9); ++rep_) { ap = kargs_opaque(); ws = ap->ws;
        pg8::Gemm g{(const pg8::bf16_t*)(ws + WS_A2), (const pg8::bf16_t*)(ws + WS_WU), ML, FF, DM};
        pg8::OrderX S; S.init(ML, FF, G, bx);
        pg8::EpiUp E{(bf16*)(ws + WS_U), (const float*)(ws + WS_SS1), (const float*)(ws + WS_CB)};
        pg8::gemm_phase<pg8::EpiUp, pg8::OrderX, true, true>(lds, g, S, E);
        }
        SEAM(9);
    }
    TSTAMP(10);
    if (IN(10)) { ap = kargs_opaque(); ws = ap->ws;
        pg8::Gemm g{(const pg8::bf16_t*)(ws + WS_U), (const pg8::bf16_t*)(ws + WS_WD), ML, DM, FF};
        pg8::OrderX S; S.init(ML, DM, G, bx);
        pg8::EpiResid<1> E{ap->out, ap->out, nullptr, (const float*)(ws + WS_MOD), nullptr, (float*)(ws + WS_SS2), 5 * 1024};
        pg8::gemm_phase<pg8::EpiResid<1>, pg8::OrderX, true, true>(lds, g, S, E);
        SEAM(10);
    }
    TSTAMP(11);
    if (IN(11)) { ap = kargs_opaque(); ws = ap->ws; phase_final(ap, vcu, G, lane, wave); }
    TSTAMP(12);
    if (PROBE_T_PHASE >= 0 && bx == 0 && tid == 0) { const unsigned long long a_ = ((unsigned long long)MISC[17] << 32) | MISC[16], b_ = ((unsigned long long)MISC[19] << 32) | MISC[18];
        __builtin_amdgcn_s_waitcnt(0); ap = kargs_opaque(); const float us_ = (float)(b_ - a_) * 0.01f; ap->out[0] += 64.0f * floorf(us_ / (float)PROBE_T_Q); }
#undef IN
#undef SEAM
}

extern "C" void kernel_launch(void* const* d_in, const int* in_sizes, int n_in, void* d_out, int out_size, void* d_ws, size_t ws_size, hipStream_t stream) {
    static int grid = 0;
    if (grid == 0) {
        if (n_in != 27 || in_sizes[0] != ML * DM || out_size != ML * DM || ws_size < WS_END) {
            fprintf(stderr, "kernel_launch: unexpected shapes (n_in %d, in0 %d, out %d, ws %zu); nothing launched\n", n_in, n_in > 0 ? in_sizes[0] : -1, out_size, ws_size); grid = -1; return; }
        int dev = 0, cus = 0, per_cu = 0;
        if (hipGetDevice(&dev) != hipSuccess || hipDeviceGetAttribute(&cus, hipDeviceAttributeMultiprocessorCount, dev) != hipSuccess) { grid = -1; return; }
        if (hipFuncSetAttribute((const void*)fwd_kernel, hipFuncAttributeMaxDynamicSharedMemorySize, LDS_BYTES) != hipSuccess) { fprintf(stderr, "kernel_launch: hipFuncSetAttribute failed\n"); grid = -1; return; }
        if (hipOccupancyMaxActiveBlocksPerMultiprocessor(&per_cu, (const void*)fwd_kernel, 512, LDS_BYTES) != hipSuccess || per_cu < 1)
            fprintf(stderr, "kernel_launch: note: occupancy query reports %d workgroups per CU\n", per_cu);
        (void)hipGetLastError();
        grid = cus;
    }
    if (grid < 0) return;
    if (hipMemsetAsync((char*)d_ws + WS_CTL, 0, CTL_ZERO_BYTES, stream) != hipSuccess) return;
#ifdef PROBE_ZERO
    (void)hipMemsetAsync((char*)d_ws + CTL_ZERO_BYTES, 0, WS_END - CTL_ZERO_BYTES, stream); (void)hipMemsetAsync(d_out, 0, (size_t)ML * DM * 4, stream);
#endif
    Args a{};
    for (int i = 0; i < 27; ++i) a.in[i] = (const float*)d_in[i];
    a.out = (float*)d_out; a.ws = (unsigned char*)d_ws;
    if (N_LAUNCHES == 1) { a.ph_lo = 0; a.ph_hi = N_PHASES; a.li = 0; hipLaunchKernelGGL(fwd_kernel, dim3(grid), dim3(512), LDS_BYTES, stream, a); }
    else for (int li = 0; li < N_PHASES; ++li) { a.ph_lo = li; a.ph_hi = li + 1; a.li = li; hipLaunchKernelGGL(fwd_kernel, dim3(grid), dim3(512), LDS_BYTES, stream, a); }
}
```
